# Optimizing an MI355X kernel written in HIP

```python
import math
import jax, jax.numpy as jnp
from jax import lax
import numpy as np

D_MODEL = 1024
BATCH = 16
SEQ = 2048
DEPTH = 2

A_GROUPS = 4
A_GROUP_DIM = 128
A_WIDTH = A_GROUPS * A_GROUP_DIM
A_CHUNK = 128
MLA_HEADS = 8
QK_NOPE = 64
QK_ROPE = 32
QK_HEAD = QK_NOPE + QK_ROPE
V_HEAD = 64
Q_LORA = 384
KV_LORA = 256
ROPE_THETA = 10000.0
Q_BLOCK = 128
MAX_POS_OFFSET = 4096
AB_IN = 2 * A_WIDTH + Q_LORA + KV_LORA + QK_ROPE
AB_OUT = A_WIDTH + MLA_HEADS * V_HEAD
S5_GROUP_DIM = 16
S5_GROUPS = D_MODEL // S5_GROUP_DIM
S5_STATE = 64
C_WIDTH = S5_GROUPS * S5_GROUP_DIM
S5_MIN_STEP = 1e-3
S5_MAX_STEP = 1e-1
D_FF = 2816
N_EXPERTS = 8
TOP_K = 2
D_EXPERT = 3584
LN_EPS = 1e-5
RMS_EPS = 1e-6
DEEPNORM_ALPHA = (2.0 * DEPTH) ** 0.25
DEEPNORM_BETA = (8.0 * DEPTH) ** -0.25

kernel_name = 'hybrid_gmlp_mla_s5_moe_deepnorm'


def layernorm(x, g, b):
    xf = x.astype(jnp.float32)
    mu = jnp.mean(xf, axis=-1, keepdims=True)
    var = jnp.mean(jnp.square(xf - mu), axis=-1, keepdims=True)
    return ((xf - mu) * lax.rsqrt(var + LN_EPS)).astype(x.dtype) * g + b


def rmsnorm(x, g):
    xf = x.astype(jnp.float32)
    ms = jnp.mean(jnp.square(xf), axis=-1, keepdims=True)
    return (xf * lax.rsqrt(ms + RMS_EPS)).astype(x.dtype) * g


def rope_cos_sin(positions, dtype):
    inv_freq = 1.0 / (ROPE_THETA ** (jnp.arange(0, QK_ROPE, 2, dtype=jnp.float32) / QK_ROPE))
    ang = positions.astype(jnp.float32)[..., None] * inv_freq
    return jnp.cos(ang).astype(dtype), jnp.sin(ang).astype(dtype)


def apply_rope(x, cos, sin):
    half = QK_ROPE // 2
    x1, x2 = x[..., :half], x[..., half:]
    return jnp.concatenate([x1 * cos - x2 * sin, x1 * sin + x2 * cos], axis=-1)


def gmlp_spatial_gating(z, ln_g, ln_b, w_s, b_s):
    bsz, seq, _ = z.shape
    u, v = jnp.split(z, 2, axis=-1)
    v = layernorm(v, ln_g, ln_b)
    v = v.reshape(bsz, seq // A_CHUNK, A_CHUNK, A_GROUPS, A_GROUP_DIM)
    w = jnp.tril(w_s)
    mixed = jnp.einsum('hts,bnshc->bnthc', w, v) + b_s.T[:, :, None]
    return u * mixed.reshape(bsz, seq, A_WIDTH)


def mla_attention(c_q, c_kv, k_pe, positions, q_norm, w_uq, kv_norm, w_ukv):
    bsz, seq, _ = c_q.shape
    q = (rmsnorm(c_q, q_norm) @ w_uq).reshape(bsz, seq, MLA_HEADS, QK_HEAD)
    q_nope, q_pe = q[..., :QK_NOPE], q[..., QK_NOPE:]
    kv = (rmsnorm(c_kv, kv_norm) @ w_ukv).reshape(bsz, seq, MLA_HEADS, QK_NOPE + V_HEAD)
    k_nope, v = kv[..., :QK_NOPE], kv[..., QK_NOPE:]
    cos, sin = rope_cos_sin(positions, c_q.dtype)
    q_pe = apply_rope(q_pe, cos[:, :, None, :], sin[:, :, None, :])
    k_pe = apply_rope(k_pe, cos, sin)
    q = jnp.concatenate([q_nope, q_pe], axis=-1)
    k = jnp.concatenate([k_nope, jnp.broadcast_to(k_pe[:, :, None, :], (bsz, seq, MLA_HEADS, QK_ROPE))], axis=-1)
    scale = QK_HEAD ** -0.5
    n_blocks = seq // Q_BLOCK
    q_blocks = q.reshape(bsz, n_blocks, Q_BLOCK, MLA_HEADS, QK_HEAD).transpose(1, 0, 2, 3, 4)
    starts = jnp.arange(n_blocks, dtype=jnp.int32) * Q_BLOCK
    key_pos = jnp.arange(seq, dtype=jnp.int32)

    def attend(args):
        qb, start = args
        s = jnp.einsum('bqhd,bkhd->bhqk', qb, k).astype(jnp.float32) * scale
        q_pos = start + jnp.arange(Q_BLOCK, dtype=jnp.int32)
        mask = key_pos[None, :] <= q_pos[:, None]
        s = jnp.where(mask, s, jnp.finfo(jnp.float32).min)
        p = jax.nn.softmax(s, axis=-1).astype(v.dtype)
        return jnp.einsum('bhqk,bkhd->bqhd', p, v)

    out = lax.map(attend, (q_blocks, starts))
    return out.transpose(1, 0, 2, 3, 4).reshape(bsz, seq, MLA_HEADS * V_HEAD)


def ab_mixer(x, positions, w_in, gm_ln_g, gm_ln_b, w_s, b_s, q_norm, w_uq, kv_norm, w_ukv, w_out):
    h = x @ w_in
    a_uv, c_q, c_kv, k_pe = jnp.split(h, [2 * A_WIDTH, 2 * A_WIDTH + Q_LORA, 2 * A_WIDTH + Q_LORA + KV_LORA], axis=-1)
    y_a = gmlp_spatial_gating(jax.nn.gelu(a_uv), gm_ln_g, gm_ln_b, w_s, b_s)
    y_b = mla_attention(c_q, c_kv, k_pe, positions, q_norm, w_uq, kv_norm, w_ukv)
    return jnp.concatenate([y_a, y_b], axis=-1) @ w_out


def _ssm_combine(e1, e2):
    a1r, a1i, b1r, b1i = e1
    a2r, a2i, b2r, b2i = e2
    return (a2r * a1r - a2i * a1i,
            a2r * a1i + a2i * a1r,
            a2r * b1r - a2i * b1i + b2r,
            a2r * b1i + a2i * b1r + b2i)


def s5_mixer(x, w_in, a_re, a_im, log_step, b_re, b_im, c_re, c_im, d_skip, glu_w, glu_b, w_out):
    bsz, seq, _ = x.shape
    f32 = jnp.float32
    u = (x @ w_in).astype(f32)
    ug = u.reshape(bsz, seq, S5_GROUPS, S5_GROUP_DIM)
    a_re, a_im = a_re.astype(f32), a_im.astype(f32)
    delta = jnp.exp(log_step.astype(f32))[:, None]
    mag = jnp.exp(delta * a_re)
    abar_re = mag * jnp.cos(delta * a_im)
    abar_im = mag * jnp.sin(delta * a_im)
    den = a_re * a_re + a_im * a_im
    coef_re = ((abar_re - 1.0) * a_re + abar_im * a_im) / den
    coef_im = (abar_im * a_re - (abar_re - 1.0) * a_im) / den
    br, bi = b_re.astype(f32), b_im.astype(f32)
    bb_re = coef_re[..., None] * br - coef_im[..., None] * bi
    bb_im = coef_re[..., None] * bi + coef_im[..., None] * br
    bu_re = jnp.einsum('bsgc,gpc->sbgp', ug, bb_re)
    bu_im = jnp.einsum('bsgc,gpc->sbgp', ug, bb_im)
    ar = jnp.broadcast_to(abar_re[None, None], (seq, 1, S5_GROUPS, S5_STATE))
    ai = jnp.broadcast_to(abar_im[None, None], (seq, 1, S5_GROUPS, S5_STATE))
    _, _, h_re, h_im = lax.associative_scan(_ssm_combine, (ar, ai, bu_re, bu_im), axis=0)
    y = (jnp.einsum('sbgp,gcp->bsgc', h_re, c_re.astype(f32))
         - jnp.einsum('sbgp,gcp->bsgc', h_im, c_im.astype(f32)))
    y = (y.reshape(bsz, seq, C_WIDTH) + d_skip.astype(f32) * u).astype(x.dtype)
    g = jax.nn.gelu(y)
    z = g * jax.nn.sigmoid(g @ glu_w + glu_b)
    return z @ w_out


def swiglu(x, w_gate, w_up, w_down):
    return (jax.nn.silu(x @ w_gate) * (x @ w_up)) @ w_down


def moe_swiglu(x, router, w_gate, w_up, w_down):
    bsz, seq, d = x.shape
    xt = x.reshape(bsz * seq, d)
    logits = (xt @ router).astype(jnp.float32)
    top_vals, top_idx = lax.top_k(logits, TOP_K)
    gates = jax.nn.softmax(top_vals, axis=-1)
    combine = jnp.sum(gates[..., None] * jax.nn.one_hot(top_idx, N_EXPERTS, dtype=jnp.float32), axis=1).astype(x.dtype)
    out = jnp.zeros_like(xt)
    for e in range(N_EXPERTS):
        out = out + combine[:, e:e + 1] * swiglu(xt, w_gate[e], w_up[e], w_down[e])
    return out.reshape(bsz, seq, d)


def setup_inputs(seed: int = 0) -> dict:
    key = jax.random.key(seed)
    keys = iter(jax.random.split(key, 64))
    ne = (DEPTH + 1) // 2
    no = DEPTH // 2

    def nrm(shape, scale):
        return jax.random.normal(next(keys), shape, jnp.float32) * scale

    def gain(shape):
        return 1.0 + nrm(shape, 0.02)

    x = jax.random.normal(next(keys), (BATCH, SEQ, D_MODEL), jnp.float32)
    offsets = jax.random.randint(next(keys), (BATCH, 1), 0, MAX_POS_OFFSET, dtype=jnp.int32)
    positions = (offsets + jnp.arange(SEQ, dtype=jnp.int32)[None, :]).astype(jnp.int32)
    log_lo, log_hi = math.log(S5_MIN_STEP), math.log(S5_MAX_STEP)
    a_im_init = math.pi * jnp.arange(S5_STATE, dtype=jnp.float32)
    return {
        'x': x,
        'positions': positions,
        'ab_w_in': nrm((ne, D_MODEL, AB_IN), D_MODEL ** -0.5),
        'gm_ln_g': gain((ne, A_WIDTH)),
        'gm_ln_b': nrm((ne, A_WIDTH), 0.02),
        'gm_w_s': nrm((ne, A_GROUPS, A_CHUNK, A_CHUNK), A_CHUNK ** -0.5),
        'gm_b_s': gain((ne, A_GROUPS, A_CHUNK)),
        'mla_q_norm': gain((ne, Q_LORA)),
        'mla_w_uq': nrm((ne, Q_LORA, MLA_HEADS * QK_HEAD), Q_LORA ** -0.5),
        'mla_kv_norm': gain((ne, KV_LORA)),
        'mla_w_ukv': nrm((ne, KV_LORA, MLA_HEADS * (QK_NOPE + V_HEAD)), KV_LORA ** -0.5),
        'ab_w_out': nrm((ne, AB_OUT, D_MODEL), AB_OUT ** -0.5 * DEEPNORM_BETA),
        'ab_ln_g': gain((ne, D_MODEL)),
        'ab_ln_b': nrm((ne, D_MODEL), 0.02),
        'ffd_w_gate': nrm((ne, D_MODEL, D_FF), D_MODEL ** -0.5),
        'ffd_w_up': nrm((ne, D_MODEL, D_FF), D_MODEL ** -0.5),
        'ffd_w_down': nrm((ne, D_FF, D_MODEL), D_FF ** -0.5 * DEEPNORM_BETA),
        'ffd_ln_g': gain((ne, D_MODEL)),
        'ffd_ln_b': nrm((ne, D_MODEL), 0.02),
        'c_w_in': nrm((no, D_MODEL, C_WIDTH), D_MODEL ** -0.5),
        's5_a_re': -0.5 * (1.0 + nrm((no, S5_GROUPS, S5_STATE), 0.02)),
        's5_a_im': a_im_init[None, None, :] + nrm((no, S5_GROUPS, S5_STATE), 0.01),
        's5_log_step': jax.random.uniform(next(keys), (no, S5_GROUPS), jnp.float32, log_lo, log_hi),
        's5_b_re': nrm((no, S5_GROUPS, S5_STATE, S5_GROUP_DIM), (2.0 * S5_GROUP_DIM) ** -0.5),
        's5_b_im': nrm((no, S5_GROUPS, S5_STATE, S5_GROUP_DIM), (2.0 * S5_GROUP_DIM) ** -0.5),
        's5_c_re': nrm((no, S5_GROUPS, S5_GROUP_DIM, S5_STATE), (2.0 * S5_STATE) ** -0.5),
        's5_c_im': nrm((no, S5_GROUPS, S5_GROUP_DIM, S5_STATE), (2.0 * S5_STATE) ** -0.5),
        's5_d': nrm((no, C_WIDTH), 1.0),
        'glu_w': nrm((no, C_WIDTH, C_WIDTH), C_WIDTH ** -0.5),
        'glu_b': nrm((no, C_WIDTH), 0.02),
        'c_w_out': nrm((no, C_WIDTH, D_MODEL), C_WIDTH ** -0.5 * DEEPNORM_BETA),
        'c_ln_g': gain((no, D_MODEL)),
        'c_ln_b': nrm((no, D_MODEL), 0.02),
        'moe_router': nrm((no, D_MODEL, N_EXPERTS), D_MODEL ** -0.5),
        'moe_w_gate': nrm((no, N_EXPERTS, D_MODEL, D_EXPERT), D_MODEL ** -0.5),
        'moe_w_up': nrm((no, N_EXPERTS, D_MODEL, D_EXPERT), D_MODEL ** -0.5),
        'moe_w_down': nrm((no, N_EXPERTS, D_EXPERT, D_MODEL), D_EXPERT ** -0.5 * DEEPNORM_BETA),
        'moe_ln_g': gain((no, D_MODEL)),
        'moe_ln_b': nrm((no, D_MODEL), 0.02),
    }


def reference(x, positions, ab_w_in, gm_ln_g, gm_ln_b, gm_w_s, gm_b_s, mla_q_norm, mla_w_uq, mla_kv_norm, mla_w_ukv, ab_w_out, ab_ln_g, ab_ln_b, ffd_w_gate, ffd_w_up, ffd_w_down, ffd_ln_g, ffd_ln_b, c_w_in, s5_a_re, s5_a_im, s5_log_step, s5_b_re, s5_b_im, s5_c_re, s5_c_im, s5_d, glu_w, glu_b, c_w_out, c_ln_g, c_ln_b, moe_router, moe_w_gate, moe_w_up, moe_w_down, moe_ln_g, moe_ln_b):
    for i in range(DEPTH):
        j = i // 2
        if i % 2 == 0:
            mix = ab_mixer(x, positions, ab_w_in[j], gm_ln_g[j], gm_ln_b[j], gm_w_s[j], gm_b_s[j],
                           mla_q_norm[j], mla_w_uq[j], mla_kv_norm[j], mla_w_ukv[j], ab_w_out[j])
            x = layernorm(DEEPNORM_ALPHA * x + mix, ab_ln_g[j], ab_ln_b[j])
            ffn = swiglu(x, ffd_w_gate[j], ffd_w_up[j], ffd_w_down[j])
            x = layernorm(DEEPNORM_ALPHA * x + ffn, ffd_ln_g[j], ffd_ln_b[j])
        else:
            mix = s5_mixer(x, c_w_in[j], s5_a_re[j], s5_a_im[j], s5_log_step[j], s5_b_re[j], s5_b_im[j],
                           s5_c_re[j], s5_c_im[j], s5_d[j], glu_w[j], glu_b[j], c_w_out[j])
            x = layernorm(DEEPNORM_ALPHA * x + mix, c_ln_g[j], c_ln_b[j])
            ffn = moe_swiglu(x, moe_router[j], moe_w_gate[j], moe_w_up[j], moe_w_down[j])
            x = layernorm(DEEPNORM_ALPHA * x + ffn, moe_ln_g[j], moe_ln_b[j])
    return x
```

```cpp
#include <hip/hip_runtime.h>
#include <cstdio>
#include <cstdint>

#ifndef MK_PER_PHASE
#define MK_PER_PHASE 1
#endif
#ifndef SKIP_AB
#define SKIP_AB 0
#endif
#ifndef SKIP_FFN
#define SKIP_FFN 0
#endif
#ifndef SKIP_S5
#define SKIP_S5 0
#endif
#ifndef SKIP_MOE
#define SKIP_MOE 0
#endif
#ifndef SKIP_ATT
#define SKIP_ATT 0
#endif
#ifndef SKIP_GATE
#define SKIP_GATE 0
#endif

#define LAS __attribute__((address_space(3)))
#define GAS __attribute__((address_space(1)))
typedef unsigned short bf16_t;
typedef short bf16x8 __attribute__((ext_vector_type(8)));
typedef short s16x4 __attribute__((ext_vector_type(4)));
typedef float f32x2 __attribute__((ext_vector_type(2)));
typedef float f32x4 __attribute__((ext_vector_type(4)));
typedef float f32x16 __attribute__((ext_vector_type(16)));
typedef unsigned u32x2 __attribute__((ext_vector_type(2)));
typedef unsigned u32x4 __attribute__((ext_vector_type(4)));
typedef GAS unsigned gu32;

constexpr int NTOK = 32768, DM = 1024, SEQ = 2048, NBATCH = 16;
constexpr int AW = 512;
constexpr int QL = 384, KVL = 256, ROPE = 32, NH = 8, QKH = 96, VH = 64;
constexpr int NIN = 1696, NIN_PAD = 1792;
constexpr int DFF = 2816, DEXP = 3584, NEXP = 8;
constexpr int S5G = 64, S5P = 64, S5L = 16;
constexpr int S5ROWS = NTOK / S5L;
constexpr int UGLD = 384;
constexpr float LN_EPS = 1e-5f, RMS_EPS = 1e-6f;
constexpr float DN_ALPHA = 1.4142135623730951f;
constexpr int MOE_TILES_MAX = 264, MOE_CHUNK = 64, MOE_NCHUNK = 5;

constexpr size_t MiB = 1u << 20, KiB = 1u << 10;
constexpr size_t WS_CTL = 0, CTL_ZERO_BYTES = 1 * MiB;
constexpr size_t CTL_BAR = 16 * KiB;
constexpr size_t CTL_SSQ = 64 * KiB;
constexpr size_t WS_CS = 1 * MiB;
constexpr size_t WS_ROUTE_E = 5 * MiB, WS_ROUTE_G = WS_ROUTE_E + 128 * KiB, WS_ROUTE_POS = WS_ROUTE_G + 256 * KiB, WS_CNTW = WS_ROUTE_POS + 256 * KiB;
constexpr size_t WS_META = WS_CNTW + 64 * KiB, WS_WSB = 5 * MiB + 768 * KiB, WS_A16 = WS_WSB + 128 * KiB;
constexpr size_t W_IN = 8 * MiB, W_UQ = W_IN + 7 * MiB / 2, W_UKV = W_UQ + 1 * MiB, W_OUT = 13 * MiB, W_GU = 15 * MiB, W_D = 26 * MiB, W_CIN = 32 * MiB, W_GLU = 34 * MiB, W_COUT = 36 * MiB;
constexpr size_t W_S1 = 38 * MiB, W_S2 = 46 * MiB, W_MGU = 58 * MiB, W_MDN = 170 * MiB, AR = 226 * MiB;
constexpr size_t A_XB = AR, A_Q = AR, A_X1B = AR, A_X2B = AR, A_Z = AR, A_XSYS = AR;
constexpr size_t A_U = AR + 64 * MiB, A_V = AR + 96 * MiB, A_CBUF = AR + 128 * MiB, A_YCAT = AR + 128 * MiB, A_KB = AR + 192 * MiB, A_VT = AR + 240 * MiB;
constexpr size_t A_HFF = AR + 64 * MiB, A_UG = AR + 64 * MiB, A_SLOC = AR + 160 * MiB, A_GACT = AR + 160 * MiB, A_X3B = AR + 160 * MiB, A_HM = AR + 132 * MiB;
constexpr size_t WS_END = AR + 272 * MiB;
static_assert(W_UKV + 512 * KiB <= W_OUT && W_S2 + 12 * MiB <= W_MGU && W_MGU + 112 * MiB == W_MDN && W_MDN + 56 * MiB == AR, "weights map");
static_assert(WS_A16 + 32 * KiB <= W_IN, "small map");

constexpr int LDS_BYTES = 153600;
constexpr int MISC_OFF = 147456;

#define LDS_WAIT() asm volatile("s_waitcnt lgkmcnt(0)" ::: "memory")
#define VM_WAIT() asm volatile("s_waitcnt vmcnt(0)" ::: "memory")
#define RLX_AGENT __ATOMIC_RELAXED, __HIP_MEMORY_SCOPE_AGENT
__device__ __forceinline__ unsigned f2bf(float f) { unsigned u = __builtin_bit_cast(unsigned, f); return (u + 0x7fffu + ((u >> 16) & 1u)) >> 16; }
__device__ __forceinline__ unsigned pk2(float lo, float hi) { return f2bf(lo) | (f2bf(hi) << 16); }
__device__ __forceinline__ float bf2f(unsigned short b) { return __builtin_bit_cast(float, ((unsigned)b) << 16); }
__device__ __forceinline__ float bflo(unsigned w) { return __builtin_bit_cast(float, w << 16); }
__device__ __forceinline__ float bfhi(unsigned w) { return __builtin_bit_cast(float, w & 0xffff0000u); }
__device__ __forceinline__ unsigned cvt_pk_bf16(float lo, float hi) { unsigned r; asm volatile("v_cvt_pk_bf16_f32 %0, %1, %2" : "=v"(r) : "v"(lo), "v"(hi)); return r; }
__device__ __forceinline__ float fast_rcp(float x) { return __builtin_amdgcn_rcpf(x); }
__device__ __forceinline__ float fast_exp(float x) { return __builtin_amdgcn_exp2f(x * 1.4426950408889634f); }
__device__ __forceinline__ float sigmoidf_(float x) { return fast_rcp(1.0f + fast_exp(-x)); }
__device__ __forceinline__ float siluf_(float x) { return x * sigmoidf_(x); }
__device__ __forceinline__ float geluf_(float x) { const float z = 0.7978845608028654f * (x + 0.044715f * x * x * x); return x * fast_rcp(1.0f + fast_exp(-2.0f * z)); }
__device__ __forceinline__ float wave_sum(float v) {
#pragma unroll
    for (int o = 1; o < 64; o <<= 1) v += __shfl_xor(v, o);
    return v;
}
__host__ __device__ __forceinline__ int perm32(int rho) { const int n = rho >> 4, i = rho & 15; return 8 * (i >> 2) + 4 * n + (i & 3); }

#define XB_TMO      128
#define XB_XCNT(j)  (256  + 64 * (j))
#define XB_XSUB(j)  (1280 + 64 * (j))
#define XB_XGEN(j)  (2304 + 64 * (j))
#define XB_TOP      3328
#define XB_TOPGEN   3392
#define XCD_BAR_WORDS 3456
#define XB_SPIN_CAP (1u << 20)
__device__ __forceinline__ unsigned xb_ld(unsigned* p)              { return __hip_atomic_load(p, __ATOMIC_RELAXED, __HIP_MEMORY_SCOPE_AGENT); }
__device__ __forceinline__ unsigned xb_add(unsigned* p, unsigned v) { return __hip_atomic_fetch_add(p, v, __ATOMIC_RELAXED, __HIP_MEMORY_SCOPE_AGENT); }
__device__ __forceinline__ unsigned xb_xcc_id() { return (unsigned)__builtin_amdgcn_s_getreg((3 << 11) | 20) & 0xFu; }
#define XB_SPIN(cond, bar) do { unsigned _sp = 0; while (cond) { __builtin_amdgcn_s_sleep(1); \
    if ((++_sp & 255u) == 0u) { if (xb_ld(&(bar)[XB_TMO])) break; if (_sp > XB_SPIN_CAP) { atomicAdd(&(bar)[XB_TMO], 1u); break; } } } } while (0)
struct XcdBarrier { unsigned* bar; unsigned x; volatile LAS unsigned* st; };
__device__ __forceinline__ XcdBarrier xcd_barrier_post(unsigned* bar, volatile LAS unsigned* st) {
    XcdBarrier b; b.bar = bar; b.x = xb_xcc_id(); b.st = st;
    if (threadIdx.x == 0) (void)xb_add(&bar[XB_XCNT(b.x)], 1u);
    return b;
}
__device__ __forceinline__ void xcd_barrier_complete(unsigned* bar, unsigned x, unsigned& nloc, unsigned& nx) {
    const unsigned G = gridDim.x * gridDim.y * gridDim.z;
    unsigned sum, cnt, mine, sp = 0u;
    for (;;) {
        sum = 0u; cnt = 0u; mine = 0u;
#pragma unroll
        for (unsigned j = 0; j < 16; ++j) { const unsigned c = xb_ld(&bar[XB_XCNT(j)]); sum += c; cnt += (c > 0u) ? 1u : 0u; mine = (j == x) ? c : mine; }
        if (sum == G) break;
        __builtin_amdgcn_s_sleep(1);
        if ((++sp & 255u) == 0u) { if (xb_ld(&bar[XB_TMO])) break; if (sp > XB_SPIN_CAP) { atomicAdd(&bar[XB_TMO], 1u); break; } }
    }
    nloc = mine > 0u ? mine : 1u; nx = cnt > 0u ? cnt : 1u;
}
__device__ __forceinline__ void xcd_barrier(const XcdBarrier& b) {
    asm volatile("s_waitcnt vmcnt(0)" ::: "memory");
    __syncthreads();
    if (threadIdx.x == 0) {
        unsigned* bar = b.bar;
        __builtin_amdgcn_s_waitcnt(0);
        unsigned nloc = b.st[0], nx = b.st[1];
        if (nloc == 0u) { xcd_barrier_complete(bar, b.x, nloc, nx); b.st[0] = nloc; b.st[1] = nx; }
        const unsigned old = xb_add(&bar[XB_XSUB(b.x)], 1u);
        const unsigned gen = old / nloc;
        if (old + 1u == (gen + 1u) * nloc) {
            __builtin_amdgcn_fence(__ATOMIC_RELEASE, "agent");
            asm volatile("s_waitcnt vmcnt(0)" ::: "memory");
            const unsigned og = xb_add(&bar[XB_TOP], 1u);
            const unsigned tg = og / nx;
            if (og + 1u == (tg + 1u) * nx) xb_add(&bar[XB_TOPGEN], 1u);
            else XB_SPIN(xb_ld(&bar[XB_TOPGEN]) == tg, bar);
            __builtin_amdgcn_fence(__ATOMIC_ACQUIRE, "agent");
            xb_add(&bar[XB_XGEN(b.x)], 1u);
            asm volatile("s_waitcnt vmcnt(0)" ::: "memory");
        } else {
            XB_SPIN(xb_ld(&bar[XB_XGEN(b.x)]) == gen, bar);
            __builtin_amdgcn_fence(__ATOMIC_ACQUIRE, "agent");
            asm volatile("s_waitcnt vmcnt(0)" ::: "memory");
        }
    }
    __syncthreads();
}

namespace pg8 {
constexpr int BM = 256, BK = 64, HALF = 128, HTB = HALF * BK * 2, STAGE_BYTES = 8 * HTB, NXCD = 8, WGM = 8;
__host__ __device__ __forceinline__ int lds_byte(int r, int c) { const int st = (r >> 4) * 2 + (c >> 5), rr = r & 15, cc = c & 31, ob = rr * 64 + cc * 2; return st * 1024 + (ob ^ (((ob >> 9) & 1) << 5)); }
__host__ __device__ __forceinline__ void stage_rc(int b, int& R, int& C) { const int st = b / 1024, sb = b % 1024, swz = sb ^ (((sb >> 9) & 1) << 5); R = (st >> 1) * 16 + swz / 64; C = (st & 1) * 32 + (swz % 64) / 2; }
struct Unit { int pm, pn, aux; const char* a; const char* b; };

template <class Epi, class Sched, bool ALIGN_EPI, bool SP2>
__device__ __forceinline__ void gemm_phase(LAS unsigned char* lds, const int lda, const int K, const Sched& S, const Epi& E) {
    int tid_ = threadIdx.x; asm volatile("" : "+v"(tid_));
    const int tid = tid_, wid = __builtin_amdgcn_readfirstlane(tid >> 6), lane = tid & 63, wr = wid >> 2, wc = wid & 3, fr = lane & 15, fq = lane >> 4;
    const int nt = K / BK;
    unsigned voffA[2], voffB[2];
#pragma unroll
    for (int i = 0; i < 2; ++i) { int R, C; stage_rc(tid * 16 + i * 8192, R, C); voffA[i] = (unsigned)(R * lda + C) * 2u; voffB[i] = (unsigned)(R * K + C) * 2u; }
    const size_t kstep = (size_t)(BK * 2);
    const size_t hstepA = (size_t)HALF * lda * 2, hstepB = (size_t)HALF * K * 2;
    const unsigned ldsw = (unsigned)wid * 1024u;
    const int aoff = lds_byte(wr * 64 + fr, fq * 8), boff = lds_byte(wc * 32 + fr, fq * 8);
#define PG8_SA(b, h) (((b) * 2 + (h)) * HTB)
#define PG8_SB(b, h) ((4 + (b) * 2 + (h)) * HTB)
#define PG8_STAGE(bufoff, gbase, voff) do { _Pragma("unroll") for (int _i = 0; _i < 2; ++_i) \
        __builtin_amdgcn_global_load_lds((const unsigned*)((const char*)(gbase) + (voff)[_i]), (LAS unsigned*)(lds + (bufoff) + ldsw + _i * 8192), 16, 0, 0); } while (0)
#define PG8_LDA(dst, b, h) do { _Pragma("unroll") for (int m = 0; m < 4; ++m) _Pragma("unroll") for (int k = 0; k < 2; ++k) dst[m][k] = *(const LAS bf16x8*)(lds + PG8_SA(b, h) + aoff + m * 2048 + k * 1024); } while (0)
#define PG8_LDB(dst, b, h) do { _Pragma("unroll") for (int n = 0; n < 2; ++n) _Pragma("unroll") for (int k = 0; k < 2; ++k) dst[n][k] = *(const LAS bf16x8*)(lds + PG8_SB(b, h) + boff + n * 2048 + k * 1024); } while (0)
#define PG8_MMA(ai, bj, At, Bt) do { __builtin_amdgcn_s_setprio(1); _Pragma("unroll") for (int m = 0; m < 4; ++m) _Pragma("unroll") for (int n = 0; n < 2; ++n) _Pragma("unroll") for (int k = 0; k < 2; ++k) \
        acc[ai][bj][m][n] = __builtin_amdgcn_mfma_f32_16x16x32_bf16(Bt[n][k], At[m][k], acc[ai][bj][m][n], 0, 0, 0); __builtin_amdgcn_s_setprio(0); } while (0)
#define PG8_WAIT_V(n) asm volatile("s_waitcnt vmcnt(" #n ")" ::: "memory")
#define PG8_WAIT_L(n) asm volatile("s_waitcnt lgkmcnt(" #n ")" ::: "memory")
#define PG8_BAR __builtin_amdgcn_s_barrier()
#define PG8_SCHED __builtin_amdgcn_sched_barrier(0)
    Unit cur, nxt; int ui = 0;
    if (!S.next(0, cur)) return;
    f32x4 acc[2][2][4][2];
#pragma unroll
    for (int a = 0; a < 2; ++a)
#pragma unroll
        for (int b = 0; b < 2; ++b)
#pragma unroll
            for (int m = 0; m < 4; ++m)
#pragma unroll
                for (int n = 0; n < 2; ++n) acc[a][b][m][n] = (f32x4){0.f, 0.f, 0.f, 0.f};
    bf16x8 At[4][2], B0[2][2], B1[2][2];
    const char* cA = cur.a; const char* cB = cur.b;
    if constexpr (SP2) {
        PG8_STAGE(PG8_SB(0, 0), cB, voffB); PG8_STAGE(PG8_SB(0, 1), cB + hstepB, voffB); PG8_STAGE(PG8_SA(0, 0), cA, voffA); PG8_STAGE(PG8_SA(0, 1), cA + hstepA, voffA);
        if (wr == 1) PG8_BAR;
        PG8_WAIT_V(2); PG8_BAR;
        PG8_STAGE(PG8_SB(1, 0), cB + kstep, voffB); PG8_STAGE(PG8_SA(1, 0), cA + kstep, voffA); PG8_STAGE(PG8_SB(1, 1), cB + hstepB + kstep, voffB);
        PG8_WAIT_V(6); PG8_BAR;
    } else {
        PG8_STAGE(PG8_SB(0, 0), cB, voffB); PG8_STAGE(PG8_SA(0, 0), cA, voffA); PG8_STAGE(PG8_SB(0, 1), cB + hstepB, voffB); PG8_STAGE(PG8_SA(0, 1), cA + hstepA, voffA);
        if (wr == 1) PG8_BAR;
        PG8_WAIT_V(4); PG8_BAR;
        PG8_STAGE(PG8_SB(1, 0), cB + kstep, voffB); PG8_STAGE(PG8_SA(1, 0), cA + kstep, voffA); PG8_STAGE(PG8_SB(1, 1), cB + hstepB + kstep, voffB);
        PG8_WAIT_V(6); PG8_BAR;
    }
    for (;;) {
        const bool has_next = S.next(ui + 1, nxt);
        const char* nA = has_next ? nxt.a : cA; const char* nB = has_next ? nxt.b : cB;
        for (int t = 0; t < nt; t += 2) {
            const bool last = (t == nt - 2);
            const char* a1 = cA + (size_t)(t + 1) * kstep;
            const char* a2 = last ? nA : cA + (size_t)(t + 2) * kstep; const char* b2 = last ? nB : cB + (size_t)(t + 2) * kstep;
            const char* a3 = a2 + kstep; const char* b3 = b2 + kstep;
            if constexpr (SP2) {
            PG8_LDB(B0, 0, 0); PG8_LDB(B1, 0, 1); PG8_SCHED; PG8_LDA(At, 0, 0); PG8_STAGE(PG8_SA(1, 1), a1 + hstepA, voffA);
            PG8_WAIT_V(8); PG8_WAIT_L(0); PG8_BAR; PG8_MMA(0, 0, At, B0); PG8_MMA(0, 1, At, B1); PG8_BAR; PG8_SCHED;
            PG8_LDA(At, 0, 1); PG8_STAGE(PG8_SB(0, 0), b2, voffB); PG8_STAGE(PG8_SB(0, 1), b2 + hstepB, voffB); PG8_STAGE(PG8_SA(0, 0), a2, voffA);
            PG8_WAIT_V(8); PG8_WAIT_L(0); PG8_BAR; PG8_MMA(1, 0, At, B0); PG8_MMA(1, 1, At, B1); PG8_BAR; PG8_SCHED;
            PG8_LDB(B0, 1, 0); PG8_LDB(B1, 1, 1); PG8_SCHED; PG8_LDA(At, 1, 0); PG8_STAGE(PG8_SA(0, 1), a2 + hstepA, voffA);
            PG8_WAIT_V(8); PG8_WAIT_L(0); PG8_BAR; PG8_MMA(0, 0, At, B0); PG8_MMA(0, 1, At, B1); PG8_BAR; PG8_SCHED;
            PG8_LDA(At, 1, 1); PG8_STAGE(PG8_SB(1, 0), b3, voffB); PG8_STAGE(PG8_SB(1, 1), b3 + hstepB, voffB); PG8_STAGE(PG8_SA(1, 0), a3, voffA);
            PG8_WAIT_V(8); PG8_WAIT_L(0); PG8_BAR; PG8_MMA(1, 0, At, B0); PG8_MMA(1, 1, At, B1); PG8_BAR; PG8_SCHED;
            } else {
            PG8_LDB(B0, 0, 0); PG8_SCHED; PG8_LDA(At, 0, 0); PG8_STAGE(PG8_SA(1, 1), a1 + hstepA, voffA);
            PG8_WAIT_L(8); PG8_BAR; PG8_WAIT_L(0); PG8_MMA(0, 0, At, B0); PG8_BAR; PG8_SCHED;
            PG8_LDB(B1, 0, 1); PG8_STAGE(PG8_SB(0, 0), b2, voffB);
            PG8_BAR; PG8_WAIT_L(0); PG8_MMA(0, 1, At, B1); PG8_BAR;
            PG8_LDA(At, 0, 1); PG8_STAGE(PG8_SA(0, 0), a2, voffA);
            PG8_BAR; PG8_WAIT_L(0); PG8_MMA(1, 0, At, B0); PG8_BAR; PG8_SCHED;
            PG8_STAGE(PG8_SB(0, 1), b2 + hstepB, voffB);
            PG8_WAIT_V(6); PG8_BAR; PG8_MMA(1, 1, At, B1); PG8_BAR;
            PG8_LDB(B0, 1, 0); PG8_SCHED; PG8_LDA(At, 1, 0); PG8_STAGE(PG8_SA(0, 1), a2 + hstepA, voffA);
            PG8_WAIT_L(8); PG8_BAR; PG8_WAIT_L(0); PG8_MMA(0, 0, At, B0); PG8_BAR; PG8_SCHED;
            PG8_LDB(B1, 1, 1); PG8_STAGE(PG8_SB(1, 0), b3, voffB);
            PG8_BAR; PG8_WAIT_L(0); PG8_MMA(0, 1, At, B1); PG8_BAR;
            PG8_LDA(At, 1, 1); PG8_STAGE(PG8_SA(1, 0), a3, voffA);
            PG8_BAR; PG8_WAIT_L(0); PG8_MMA(1, 0, At, B0); PG8_BAR; PG8_SCHED;
            PG8_STAGE(PG8_SB(1, 1), b3 + hstepB, voffB);
            PG8_WAIT_V(6); PG8_BAR; PG8_MMA(1, 1, At, B1); PG8_BAR;
            }
        }
        if constexpr (ALIGN_EPI) { if (wr == 0) PG8_BAR; }
        E(acc, cur, wr, wc, fr, fq);
        if (!has_next) break;
#pragma unroll
        for (int a = 0; a < 2; ++a)
#pragma unroll
            for (int b = 0; b < 2; ++b)
#pragma unroll
                for (int m = 0; m < 4; ++m)
#pragma unroll
                    for (int n = 0; n < 2; ++n) acc[a][b][m][n] = (f32x4){0.f, 0.f, 0.f, 0.f};
        cur = nxt; cA = nA; cB = nB; ++ui;
        if constexpr (ALIGN_EPI) { if (wr == 1) PG8_BAR; }
    }
    PG8_WAIT_V(0);
    if constexpr (!ALIGN_EPI) { if (wr == 0) PG8_BAR; }
    PG8_BAR;
#undef PG8_SA
#undef PG8_SB
#undef PG8_STAGE
#undef PG8_LDA
#undef PG8_LDB
#undef PG8_MMA
#undef PG8_WAIT_V
#undef PG8_WAIT_L
#undef PG8_BAR
#undef PG8_SCHED
}

struct SchedPlain {
    int nM, nN, nwg, G, c; const char* A; const char* Bt; size_t tA, tB;
    __device__ __forceinline__ void init(int M, int N, int G_, int c_, const void* A_, int lda, const void* Bt_, int K) { nM = M / BM; nN = N / BM; nwg = nM * nN; G = G_; c = c_; A = (const char*)A_; Bt = (const char*)Bt_; tA = (size_t)BM * lda * 2; tB = (size_t)BM * K * 2; }
    __device__ __forceinline__ bool next(int i, Unit& u) const {
        const long L = (long)i * G + c; if (L >= nwg) return false;
        int wgid = (int)L; { const int q = nwg / NXCD, r = nwg % NXCD, xcd = wgid % NXCD, off = wgid / NXCD; wgid = (xcd < r ? xcd * (q + 1) : r * (q + 1) + (xcd - r) * q) + off; }
        const int nig = WGM * nN, gid = wgid / nig, fm = gid * WGM, gsz = (nM - fm) < WGM ? (nM - fm) : WGM;
        u.pm = fm + ((wgid % nig) % gsz); u.pn = (wgid % nig) / gsz; u.aux = 0;
        u.a = A + (size_t)u.pm * tA; u.b = Bt + (size_t)u.pn * tB; return true;
    }
};
struct SchedS5 {
    int G, c; const char* A; const char* Bt; size_t gA, gB, tA;
    __device__ __forceinline__ bool next(int i, Unit& u) const {
        const int L = i * G + c; if (L >= S5G * 8) return false;
        u.pn = L >> 3; u.pm = L & 7; u.aux = 0; u.a = A + (size_t)u.pn * gA + (size_t)u.pm * tA; u.b = Bt + (size_t)u.pn * gB; return true;
    }
};
struct SchedMoE {
    int G, c, t0, nt, nN; const int* rowbase; const char* A; const char* Bt; size_t tA, eB, tB;
    bool a_global;
    __device__ __forceinline__ bool next(int i, Unit& u) const {
        const int L = i * G + c; if (L >= nt * nN) return false;
        const int pn = L / nt, tl = L % nt, tile = t0 + tl; int e = 0;
#pragma unroll
        for (int j = 1; j < NEXP; ++j) e += (rowbase[j] <= tile * 256) ? 1 : 0;
        u.pm = tl; u.pn = pn; u.aux = tile; u.a = A + (size_t)(a_global ? tile : tl) * tA; u.b = Bt + (size_t)e * eB + (size_t)pn * tB; return true;
    }
};
}
using pg8::Unit;

struct Args { const void* in[39]; float* out; unsigned char* ws; int ph_lo, ph_hi, ck_lo, ck_hi; };
typedef const __attribute__((address_space(4))) Args* ArgsP;
__device__ __forceinline__ ArgsP args_now() { ArgsP p = (ArgsP)__builtin_amdgcn_kernarg_segment_ptr(); asm volatile("" : "+s"(p)); return p; }
struct Frame {
    LAS unsigned char* lds; unsigned char* gl;
    unsigned char* ws; float* out;
    int tid, lane, wave, G, bid;
};
#define INF(i) ((const float*)args->in[i])

#define EPI_OPAQUE int fr = fr_, fq = fq_; asm volatile("" : "+v"(fr), "+v"(fq));
#define EPI_ROWS_BEGIN  _Pragma("unroll") for (int ai = 0; ai < 2; ++ai) _Pragma("unroll") for (int m = 0; m < 4; ++m) { const int rl = ai * 128 + wr * 64 + m * 16 + fr;
#define EPI_ROWS_END asm volatile("" ::: "memory"); }
__device__ __forceinline__ u32x4 pack8(const f32x4 v0, const f32x4 v1) { u32x4 w; w.x = cvt_pk_bf16(v0[0], v0[1]); w.y = cvt_pk_bf16(v0[2], v0[3]); w.z = cvt_pk_bf16(v1[0], v1[1]); w.w = cvt_pk_bf16(v1[2], v1[3]); return w; }

struct EpiIn {
    bf16_t* U; bf16_t* V; bf16_t* C; bf16_t* Kb; float* ssq; const float* cs;
    __device__ __forceinline__ void operator()(const f32x4 (&acc)[2][2][4][2], const Unit& u, int wr, int wc, int fr_, int fq_) const {
        EPI_OPAQUE
        EPI_ROWS_BEGIN
            const size_t row = (size_t)u.pm * 256 + rl;
#pragma unroll
            for (int bj = 0; bj < 2; ++bj) {
                const int gi = u.pn * 8 + bj * 4 + wc;
                f32x4 v0 = acc[ai][bj][m][0], v1 = acc[ai][bj][m][1];
                if (gi < 32) {
#pragma unroll
                    for (int j = 0; j < 4; ++j) { v0[j] = geluf_(v0[j]); v1[j] = geluf_(v1[j]); }
                    bf16_t* dst = (gi < 16) ? (U + row * AW + gi * 32 + 8 * fq) : (V + row * AW + (gi - 16) * 32 + 8 * fq);
                    *(u32x4*)dst = pack8(v0, v1);
                } else if (gi < 52) {
                    *(u32x4*)(C + row * 768 + (gi - 32) * 32 + 8 * fq) = pack8(v0, v1);
                    float ss = (v0[0] * v0[0] + v0[1] * v0[1]) + (v0[2] * v0[2] + v0[3] * v0[3]) + (v1[0] * v1[0] + v1[1] * v1[1]) + (v1[2] * v1[2] + v1[3] * v1[3]);
                    ss += __shfl_xor(ss, 16); ss += __shfl_xor(ss, 32);
                    if (fq == 0) unsafeAtomicAdd(ssq + row * 2 + (gi >= 44 ? 1 : 0), ss);
                } else if (gi == 52) {
                    const f32x4 cc = *(const f32x4*)(cs + row * 32 + 4 * fq), sn = *(const f32x4*)(cs + row * 32 + 16 + 4 * fq);
                    const f32x4 o1 = v0 * cc - v1 * sn, o2 = v0 * sn + v1 * cc;
                    u32x2 w1, w2; w1.x = cvt_pk_bf16(o1[0], o1[1]); w1.y = cvt_pk_bf16(o1[2], o1[3]); w2.x = cvt_pk_bf16(o2[0], o2[1]); w2.y = cvt_pk_bf16(o2[2], o2[3]);
#pragma unroll
                    for (int h = 0; h < NH; ++h) { *(u32x2*)(Kb + row * 768 + h * QKH + 64 + 4 * fq) = w1; *(u32x2*)(Kb + row * 768 + h * QKH + 80 + 4 * fq) = w2; }
                }
            }
        EPI_ROWS_END
    }
};
struct EpiQ {
    bf16_t* Q; const float* ssq; const float* cs;
    __device__ __forceinline__ void operator()(const f32x4 (&acc)[2][2][4][2], const Unit& u, int wr, int wc, int fr_, int fq_) const {
        EPI_OPAQUE
        EPI_ROWS_BEGIN
            const size_t row = (size_t)u.pm * 256 + rl;
            const float rstd = __builtin_amdgcn_rsqf(ssq[row * 2] * (1.0f / QL) + RMS_EPS);
#pragma unroll
            for (int bj = 0; bj < 2; ++bj) {
                const int gi = u.pn * 8 + bj * 4 + wc;
                const f32x4 v0 = acc[ai][bj][m][0] * rstd, v1 = acc[ai][bj][m][1] * rstd;
                if (gi % 3 != 2) { *(u32x4*)(Q + row * 768 + gi * 32 + 8 * fq) = pack8(v0, v1); }
                else {
                    const f32x4 cc = *(const f32x4*)(cs + row * 32 + 4 * fq), sn = *(const f32x4*)(cs + row * 32 + 16 + 4 * fq);
                    const f32x4 o1 = v0 * cc - v1 * sn, o2 = v0 * sn + v1 * cc;
                    u32x2 w1, w2; w1.x = cvt_pk_bf16(o1[0], o1[1]); w1.y = cvt_pk_bf16(o1[2], o1[3]); w2.x = cvt_pk_bf16(o2[0], o2[1]); w2.y = cvt_pk_bf16(o2[2], o2[3]);
                    *(u32x2*)(Q + row * 768 + gi * 32 + 4 * fq) = w1; *(u32x2*)(Q + row * 768 + gi * 32 + 16 + 4 * fq) = w2;
                }
            }
        EPI_ROWS_END
    }
};
struct EpiKV {
    bf16_t* Kb; bf16_t* Vt; const float* ssq;
    __device__ __forceinline__ void operator()(const f32x4 (&acc)[2][2][4][2], const Unit& u, int wr, int wc, int fr_, int fq_) const {
        EPI_OPAQUE
        EPI_ROWS_BEGIN
            const size_t row = (size_t)u.pm * 256 + rl;
            const float rstd = __builtin_amdgcn_rsqf(ssq[row * 2 + 1] * (1.0f / KVL) + RMS_EPS);
            const int b = (int)(row >> 11), s = (int)(row & 2047);
#pragma unroll
            for (int bj = 0; bj < 2; ++bj) {
                const int head = u.pn * 2 + bj;
                const f32x4 v0 = acc[ai][bj][m][0] * rstd, v1 = acc[ai][bj][m][1] * rstd;
                if (wc < 2) { *(u32x4*)(Kb + row * 768 + head * QKH + wc * 32 + 8 * fq) = pack8(v0, v1); }
                else {
                    const int d0 = (wc - 2) * 32 + 8 * fq; bf16_t* vp = Vt + ((size_t)(b * NH + head) * VH + d0) * SEQ + s;
#pragma unroll
                    for (int j = 0; j < 4; ++j) { vp[(size_t)j * SEQ] = (bf16_t)f2bf(v0[j]); vp[(size_t)(4 + j) * SEQ] = (bf16_t)f2bf(v1[j]); }
                }
            }
        EPI_ROWS_END
    }
};
struct EpiRes {
    const float* res; float* out;
    __device__ __forceinline__ void operator()(const f32x4 (&acc)[2][2][4][2], const Unit& u, int wr, int wc, int fr_, int fq_) const {
        EPI_OPAQUE
        EPI_ROWS_BEGIN
            const size_t off = ((size_t)u.pm * 256 + rl) * DM + u.pn * 256 + wc * 32 + 4 * fq;
#pragma unroll
            for (int bj = 0; bj < 2; ++bj)
#pragma unroll
                for (int n = 0; n < 2; ++n) { const size_t o = off + bj * 128 + n * 16; const f32x4 r = *(const f32x4*)(res + o); *(f32x4*)(out + o) = r * DN_ALPHA + acc[ai][bj][m][n]; }
        EPI_ROWS_END
    }
};
struct EpiGU {
    bf16_t* H; int ldh;
    __device__ __forceinline__ void operator()(const f32x4 (&acc)[2][2][4][2], const Unit& u, int wr, int wc, int fr_, int fq_) const {
        EPI_OPAQUE
        EPI_ROWS_BEGIN
            f32x4 h0, h1;
#pragma unroll
            for (int j = 0; j < 4; ++j) { h0[j] = siluf_(acc[ai][0][m][0][j]) * acc[ai][1][m][0][j]; h1[j] = siluf_(acc[ai][0][m][1][j]) * acc[ai][1][m][1][j]; }
            *(u32x4*)(H + ((size_t)u.pm * 256 + rl) * ldh + u.pn * 128 + wc * 32 + 8 * fq) = pack8(h0, h1);
        EPI_ROWS_END
    }
};
struct EpiCin {
    bf16_t* Ug;
    __device__ __forceinline__ void operator()(const f32x4 (&acc)[2][2][4][2], const Unit& u, int wr, int wc, int fr_, int fq_) const {
        EPI_OPAQUE
        EPI_ROWS_BEGIN
            const int row = u.pm * 256 + rl;
#pragma unroll
            for (int bj = 0; bj < 2; ++bj) {
                const int L0 = u.pn * 256 + bj * 128 + wc * 32 + 8 * fq, g = L0 >> 4, c0 = L0 & 15;
                *(u32x4*)(Ug + (size_t)g * (S5ROWS * UGLD) + (size_t)(row >> 4) * UGLD + (row & 15) * 16 + c0) = pack8(acc[ai][bj][m][0], acc[ai][bj][m][1]);
            }
        EPI_ROWS_END
    }
};
struct EpiS1 {
    float* Sloc;
    __device__ __forceinline__ void operator()(const f32x4 (&acc)[2][2][4][2], const Unit& u, int wr, int wc, int fr_, int fq_) const {
        EPI_OPAQUE
        EPI_ROWS_BEGIN
            float* p = Sloc + ((size_t)u.pn * S5ROWS + u.pm * 256 + rl) * 128 + wc * 32 + 8 * fq;
            *(f32x4*)p = acc[ai][0][m][0]; *(f32x4*)(p + 4) = acc[ai][0][m][1];
        EPI_ROWS_END
    }
};
struct EpiS2 {
    const bf16_t* Ug; const float* dsk; bf16_t* gact;
    __device__ __forceinline__ void operator()(const f32x4 (&acc)[2][2][4][2], const Unit& u, int wr, int wc, int fr_, int fq_) const {
        EPI_OPAQUE
        const int g = u.pn;
        EPI_ROWS_BEGIN
            const int rho = u.pm * 256 + rl;
#pragma unroll
            for (int bj = 0; bj < 2; ++bj) {
                const int l0 = bj * 128 + wc * 32 + 8 * fq, jp = l0 >> 4, c0 = l0 & 15, ch0 = g * 16 + c0;
                const u32x4 uu = *(const u32x4*)(Ug + (size_t)g * (S5ROWS * UGLD) + (size_t)rho * UGLD + l0);
                const f32x4 d0 = *(const f32x4*)(dsk + ch0), d1 = *(const f32x4*)(dsk + ch0 + 4);
                f32x4 y0 = acc[ai][bj][m][0], y1 = acc[ai][bj][m][1];
                y0[0] += d0[0] * bflo(uu.x); y0[1] += d0[1] * bfhi(uu.x); y0[2] += d0[2] * bflo(uu.y); y0[3] += d0[3] * bfhi(uu.y);
                y1[0] += d1[0] * bflo(uu.z); y1[1] += d1[1] * bfhi(uu.z); y1[2] += d1[2] * bflo(uu.w); y1[3] += d1[3] * bfhi(uu.w);
#pragma unroll
                for (int j = 0; j < 4; ++j) { y0[j] = geluf_(y0[j]); y1[j] = geluf_(y1[j]); }
                *(u32x4*)(gact + ((size_t)rho * 16 + jp) * DM + ch0) = pack8(y0, y1);
            }
        EPI_ROWS_END
    }
};
struct EpiGlu {
    const bf16_t* gact; const float* gb; bf16_t* Z;
    __device__ __forceinline__ void operator()(const f32x4 (&acc)[2][2][4][2], const Unit& u, int wr, int wc, int fr_, int fq_) const {
        EPI_OPAQUE
        EPI_ROWS_BEGIN
            const size_t row = (size_t)u.pm * 256 + rl;
#pragma unroll
            for (int bj = 0; bj < 2; ++bj) {
                const int col0 = u.pn * 256 + bj * 128 + wc * 32 + 8 * fq;
                const u32x4 gg = *(const u32x4*)(gact + row * DM + col0);
                const f32x4 b0 = *(const f32x4*)(gb + col0), b1 = *(const f32x4*)(gb + col0 + 4);
                f32x4 z0, z1;
                z0[0] = bflo(gg.x) * sigmoidf_(acc[ai][bj][m][0][0] + b0[0]); z0[1] = bfhi(gg.x) * sigmoidf_(acc[ai][bj][m][0][1] + b0[1]);
                z0[2] = bflo(gg.y) * sigmoidf_(acc[ai][bj][m][0][2] + b0[2]); z0[3] = bfhi(gg.y) * sigmoidf_(acc[ai][bj][m][0][3] + b0[3]);
                z1[0] = bflo(gg.z) * sigmoidf_(acc[ai][bj][m][1][0] + b1[0]); z1[1] = bfhi(gg.z) * sigmoidf_(acc[ai][bj][m][1][1] + b1[1]);
                z1[2] = bflo(gg.w) * sigmoidf_(acc[ai][bj][m][1][2] + b1[2]); z1[3] = bfhi(gg.w) * sigmoidf_(acc[ai][bj][m][1][3] + b1[3]);
                *(u32x4*)(Z + row * DM + col0) = pack8(z0, z1);
            }
        EPI_ROWS_END
    }
};
struct EpiDn {
    bf16_t* Ys;
    __device__ __forceinline__ void operator()(const f32x4 (&acc)[2][2][4][2], const Unit& u, int wr, int wc, int fr_, int fq_) const {
        EPI_OPAQUE
        EPI_ROWS_BEGIN
#pragma unroll
            for (int bj = 0; bj < 2; ++bj)
                *(u32x4*)(Ys + ((size_t)u.aux * 256 + rl) * DM + u.pn * 256 + bj * 128 + wc * 32 + 8 * fq) = pack8(acc[ai][bj][m][0], acc[ai][bj][m][1]);
        EPI_ROWS_END
    }
};

__device__ __forceinline__ void tr_item(const float* src, int ld, int scol0, bf16_t* dst, int K, int drow0, int k0, bool perm, const float* kscale, float cscale, LAS float* scr, int lane) {
#pragma unroll 8
    for (int i = 0; i < 32; ++i) { const int kk = 2 * i + (lane >> 5); float v = src[(size_t)(k0 + kk) * ld + scol0 + (lane & 31)] * cscale; if (kscale) v *= kscale[k0 + kk]; scr[kk * 33 + (lane & 31)] = v; }
    LDS_WAIT(); asm volatile("" ::: "memory");
    const int c = lane & 7;
#pragma unroll
    for (int j = 0; j < 4; ++j) { const int rho = (lane >> 3) + 8 * j; const int sc = perm ? perm32(rho) : rho; const LAS float* s = scr + (8 * c) * 33 + sc;
        u32x4 o; o.x = pk2(s[0 * 33], s[1 * 33]); o.y = pk2(s[2 * 33], s[3 * 33]); o.z = pk2(s[4 * 33], s[5 * 33]); o.w = pk2(s[6 * 33], s[7 * 33]);
        *(u32x4*)(dst + (size_t)(drow0 + rho) * K + k0 + 8 * c) = o; }
    LDS_WAIT(); asm volatile("" ::: "memory");
}
__device__ __forceinline__ void zero_item(bf16_t* dst, int K, int drow0, int k0, int lane) {
    const int c = lane & 7;
#pragma unroll
    for (int j = 0; j < 4; ++j) { const int rho = (lane >> 3) + 8 * j; *(u32x4*)(dst + (size_t)(drow0 + rho) * K + k0 + 8 * c) = (u32x4){0u, 0u, 0u, 0u}; }
}
__device__ __forceinline__ void sincos_rev(double t, double& c, double& s) {
    t -= rint(t); const double kq = rint(t * 4.0); const int k = (int)kq; const double r = (t - 0.25 * kq) * 6.283185307179586476925; const double r2 = r * r;
    const double sn = r * (1.0 + r2 * (-1.0 / 6 + r2 * (1.0 / 120 + r2 * (-1.0 / 5040 + r2 * (1.0 / 362880 + r2 * (-1.0 / 39916800 + r2 * (1.0 / 6227020800.0)))))));
    const double cn = 1.0 + r2 * (-0.5 + r2 * (1.0 / 24 + r2 * (-1.0 / 720 + r2 * (1.0 / 40320 + r2 * (-1.0 / 3628800 + r2 * (1.0 / 479001600 + r2 * (-1.0 / 87178291200.0)))))));
    switch (k & 3) { case 0: c = cn; s = sn; break; case 1: c = -sn; s = cn; break; case 2: c = -cn; s = -sn; break; default: c = sn; s = -cn; break; }
}
__device__ __forceinline__ void s5_prepare(ArgsP args, Frame& F, int g) {
    f32x2* AP = (f32x2*)(F.gl);
    f32x2* Bb = (f32x2*)(F.gl + 8704);
    f32x2* Cc = (f32x2*)(F.gl + 8704 + 8192);
    float* Kt = (float*)(F.gl + 8704 + 16384);
    const float* a_re = INF(20) + g * S5P; const float* a_im = INF(21) + g * S5P; const float* b_re = INF(23) + (size_t)g * S5P * 16; const float* b_im = INF(24) + (size_t)g * S5P * 16;
    const float* c_re = INF(25) + (size_t)g * 16 * S5P; const float* c_im = INF(26) + (size_t)g * 16 * S5P;
    const int tid = F.tid;
    if (tid < 64) {
        const int p = tid; const double dl = exp((double)INF(22)[g]); const double are = (double)a_re[p], aim = (double)a_im[p];
        double abr = 1.0, abi = 0.0;
        for (int tau = 0; tau <= 16; ++tau) { const double mg = exp(dl * are * tau); double c, s; sincos_rev(dl * aim * tau * 0.15915494309189533577, c, s); AP[tau * 64 + p] = (f32x2){(float)(mg * c), (float)(mg * s)}; if (tau == 1) { abr = mg * c; abi = mg * s; } }
        const double den = are * are + aim * aim; const double cr = ((abr - 1.0) * are + abi * aim) / den, ci = (abi * are - (abr - 1.0) * aim) / den;
        for (int c = 0; c < 16; ++c) { const double br = (double)b_re[p * 16 + c], bi = (double)b_im[p * 16 + c]; Bb[p * 16 + c] = (f32x2){(float)(cr * br - ci * bi), (float)(cr * bi + ci * br)}; }
        ((f32x2*)(F.ws + WS_A16))[g * 64 + p] = AP[16 * 64 + p];
    }
    for (int i = tid; i < 1024; i += 512) Cc[i] = (f32x2){c_re[i], c_im[i]};
    __syncthreads();
    for (int e = tid; e < 4096; e += 512) {
        const int tau = e >> 8, cp = (e >> 4) & 15, c = e & 15; float a = 0.f;
        for (int p = 0; p < 64; ++p) { const f32x2 C = Cc[cp * 64 + p], A = AP[tau * 64 + p], B = Bb[p * 16 + c]; const float gr = C.x * A.x - C.y * A.y, gi = C.x * A.y + C.y * A.x; a += gr * B.x - gi * B.y; }
        Kt[e] = a;
    }
    __syncthreads();
    bf16_t* S2 = (bf16_t*)(F.ws + W_S2) + (size_t)g * 256 * UGLD; bf16_t* S1 = (bf16_t*)(F.ws + W_S1) + (size_t)g * 256 * 256;
    for (int pc = tid; pc < 256 * 48; pc += 512) {
        const int n = pc / 48, k0 = (pc % 48) * 8; const int l = (n & ~31) + perm32(n & 31), jp = l >> 4, cp = l & 15; float v[8];
        if (k0 < 256) { const int j = k0 >> 4, c0 = k0 & 15;
#pragma unroll
            for (int i = 0; i < 8; ++i) v[i] = (j <= jp) ? Kt[((jp - j) * 16 + cp) * 16 + c0 + i] : 0.f;
        } else { const int q0 = k0 - 256;
#pragma unroll
            for (int i = 0; i < 8; ++i) { const int q = q0 + i, p = q & 63; const f32x2 C = Cc[cp * 64 + p], A = AP[(jp + 1) * 64 + p]; const float gr = C.x * A.x - C.y * A.y, gi = C.x * A.y + C.y * A.x; v[i] = (q < 64) ? gr : -gi; } }
        u32x4 o; o.x = pk2(v[0], v[1]); o.y = pk2(v[2], v[3]); o.z = pk2(v[4], v[5]); o.w = pk2(v[6], v[7]); *(u32x4*)(S2 + (size_t)n * UGLD + k0) = o;
    }
    for (int pc = tid; pc < 256 * 32; pc += 512) {
        const int n = pc >> 5, k0 = (pc & 31) * 8; float v[8];
        if (n < 128) { const int l = (n & ~31) + perm32(n & 31), p = l & 63, j = k0 >> 4, c0 = k0 & 15; const f32x2 A = AP[(15 - j) * 64 + p];
#pragma unroll
            for (int i = 0; i < 8; ++i) { const f32x2 B = Bb[p * 16 + c0 + i]; v[i] = (l < 64) ? (A.x * B.x - A.y * B.y) : (A.x * B.y + A.y * B.x); }
        } else {
#pragma unroll
            for (int i = 0; i < 8; ++i) v[i] = 0.f; }
        u32x4 o; o.x = pk2(v[0], v[1]); o.y = pk2(v[2], v[3]); o.z = pk2(v[4], v[5]); o.w = pk2(v[6], v[7]); *(u32x4*)(S1 + (size_t)n * 256 + k0) = o;
    }
    __syncthreads();
}
__device__ __forceinline__ void p0_prologue(ArgsP args, Frame& F) {
    if (F.bid < S5G) s5_prepare(args, F, F.bid);
    LAS float* scr = (LAS float*)(F.lds + F.wave * 16384);
    const int gw = F.bid * 8 + F.wave, NGW = F.G * 8, lane = F.lane;
    unsigned char* ws = F.ws;
    constexpr int I_IN = 16 * 56, I_UQ = 6 * 24, I_UKV = 4 * 32, I_SQ = 16 * 32, I_GU = 16 * 176, I_D = 44 * 32, I_MGU = 16 * 224, I_MDN = 56 * 32;
    constexpr int NITEMS = I_IN + I_UQ + I_UKV + 4 * I_SQ + I_GU + I_D + NEXP * (I_MGU + I_MDN);
    for (int it = gw; it < NITEMS; it += NGW) {
        int r = it;
        if (r < I_IN) { const int kb = r / 56, gi = r % 56; if (gi < 53) tr_item(INF(2), NIN, gi * 32, (bf16_t*)(ws + W_IN), DM, gi * 32, kb * 64, gi != 52, nullptr, 1.f, scr, lane); else zero_item((bf16_t*)(ws + W_IN), DM, gi * 32, kb * 64, lane); continue; } r -= I_IN;
        if (r < I_UQ) { const int kb = r / 24, gi = r % 24; tr_item(INF(8), NH * QKH, gi * 32, (bf16_t*)(ws + W_UQ), QL, gi * 32, kb * 64, (gi % 3) != 2, INF(7), 0.10206207261596575f * 1.4426950408889634f  , scr, lane); continue; } r -= I_UQ;
        if (r < I_UKV) { const int kb = r / 32, gi = r % 32; tr_item(INF(10), NH * 128, gi * 32, (bf16_t*)(ws + W_UKV), KVL, gi * 32, kb * 64, true, INF(9), 1.f, scr, lane); continue; } r -= I_UKV;
        if (r < I_SQ) { const int kb = r / 32, gi = r % 32; tr_item(INF(11), DM, gi * 32, (bf16_t*)(ws + W_OUT), DM, gi * 32, kb * 64, false, nullptr, 1.f, scr, lane); continue; } r -= I_SQ;
        if (r < I_SQ) { const int kb = r / 32, gi = r % 32; tr_item(INF(19), DM, gi * 32, (bf16_t*)(ws + W_CIN), DM, gi * 32, kb * 64, true, nullptr, 1.f, scr, lane); continue; } r -= I_SQ;
        if (r < I_SQ) { const int kb = r / 32, gi = r % 32; tr_item(INF(28), DM, gi * 32, (bf16_t*)(ws + W_GLU), DM, gi * 32, kb * 64, true, nullptr, 1.f, scr, lane); continue; } r -= I_SQ;
        if (r < I_SQ) { const int kb = r / 32, gi = r % 32; tr_item(INF(30), DM, gi * 32, (bf16_t*)(ws + W_COUT), DM, gi * 32, kb * 64, false, nullptr, 1.f, scr, lane); continue; } r -= I_SQ;
        if (r < I_GU) { const int kb = r / 176, gi = r % 176, tile = gi >> 3, w8 = gi & 7; tr_item(w8 < 4 ? INF(14) : INF(15), DFF, tile * 128 + (w8 & 3) * 32, (bf16_t*)(ws + W_GU), DM, gi * 32, kb * 64, true, nullptr, 1.f, scr, lane); continue; } r -= I_GU;
        if (r < I_D) { const int kb = r / 32, gi = r % 32; tr_item(INF(16), DM, gi * 32, (bf16_t*)(ws + W_D), DFF, gi * 32, kb * 64, false, nullptr, 1.f, scr, lane); continue; } r -= I_D;
        if (r < NEXP * I_MGU) { const int e = r / I_MGU, rr = r % I_MGU, kb = rr / 224, gi = rr % 224, tile = gi >> 3, w8 = gi & 7;
            tr_item((w8 < 4 ? INF(34) : INF(35)) + (size_t)e * DM * DEXP, DEXP, tile * 128 + (w8 & 3) * 32, (bf16_t*)(ws + W_MGU) + (size_t)e * 7168 * DM, DM, gi * 32, kb * 64, true, nullptr, 1.f, scr, lane); continue; } r -= NEXP * I_MGU;
        { const int e = r / I_MDN, rr = r % I_MDN, kb = rr / 32, gi = rr % 32;
            tr_item(INF(36) + (size_t)e * DEXP * DM, DM, gi * 32, (bf16_t*)(ws + W_MDN) + (size_t)e * DM * DEXP, DEXP, gi * 32, kb * 64, true, nullptr, 1.f, scr, lane); }
    }
    { const f32x4* xs = (const f32x4*)INF(0); u32x2* xd = (u32x2*)(ws + A_XB); const size_t n4 = (size_t)NTOK * DM / 4;
      for (size_t i = (size_t)F.bid * 512 + F.tid; i < n4; i += (size_t)F.G * 512) { const f32x4 v = xs[i]; u32x2 o; o.x = pk2(v[0], v[1]); o.y = pk2(v[2], v[3]); xd[i] = o; } }
    { const int* pos = (const int*)args->in[1]; float* cs = (float*)(ws + WS_CS);
      for (int i = F.bid * 512 + F.tid; i < NTOK * 16; i += F.G * 512) { const int t = i >> 4, f = i & 15; double inv = 1.0; for (int q = 0; q < f; ++q) inv *= 0.56234132519034908039; double c, s; sincos_rev((double)pos[t] * inv * 0.15915494309189533577, c, s); cs[t * 32 + f] = (float)c; cs[t * 32 + 16 + f] = (float)s; } }
    { const float* w = INF(5); bf16_t* wd = (bf16_t*)(ws + WS_WSB);
      for (int i = F.bid * 512 + F.tid; i < 4 * 128 * 128; i += F.G * 512) { const int t = (i >> 7) & 127, s = i & 127; wd[i] = (bf16_t)f2bf(s <= t ? w[i] : 0.f); } }
}

__device__ __forceinline__ void ln_core(f32x4 (&v)[4], const float* g, const float* b, int lane) {
    float s = 0.f;
#pragma unroll
    for (int j = 0; j < 4; ++j) s += (v[j][0] + v[j][1]) + (v[j][2] + v[j][3]);
    const float mean = wave_sum(s) * (1.0f / DM); float q = 0.f;
#pragma unroll
    for (int j = 0; j < 4; ++j) { v[j] = v[j] - mean; q += (v[j][0] * v[j][0] + v[j][1] * v[j][1]) + (v[j][2] * v[j][2] + v[j][3] * v[j][3]); }
    const float rstd = 1.0f / sqrtf(wave_sum(q) * (1.0f / DM) + LN_EPS);
#pragma unroll
    for (int j = 0; j < 4; ++j) { const f32x4 gg = *(const f32x4*)(g + 4 * lane + 256 * j), bb = *(const f32x4*)(b + 4 * lane + 256 * j); v[j] = v[j] * rstd * gg + bb; }
}
__device__ __forceinline__ void ln_pass(Frame& F, const float* g, const float* b, bf16_t* xb) {
    const int gw = F.bid * 8 + F.wave, NGW = F.G * 8, lane = F.lane;
    for (int row = gw; row < NTOK; row += NGW) {
        float* xr = F.out + (size_t)row * DM; f32x4 v[4];
#pragma unroll
        for (int j = 0; j < 4; ++j) v[j] = *(const f32x4*)(xr + 4 * lane + 256 * j);
        ln_core(v, g, b, lane);
#pragma unroll
        for (int j = 0; j < 4; ++j) { *(f32x4*)(xr + 4 * lane + 256 * j) = v[j]; u32x2 o; o.x = pk2(v[j][0], v[j][1]); o.y = pk2(v[j][2], v[j][3]); *(u32x2*)(xb + (size_t)row * DM + 4 * lane + 256 * j) = o; }
    }
}
__device__ __forceinline__ void scale_pass(Frame& F, const float* res) {
    const size_t n4 = (size_t)NTOK * DM / 4;
    for (size_t i = (size_t)F.bid * 512 + F.tid; i < n4; i += (size_t)F.G * 512) ((f32x4*)F.out)[i] = ((const f32x4*)res)[i] * DN_ALPHA;
}
__device__ __forceinline__ void ln3_router_pass(ArgsP args, Frame& F) {
    float* Rt = (float*)F.gl;
    const float* router = INF(33);
    for (int i = F.tid; i < DM * NEXP; i += 512) { const int k = i >> 3, e = i & 7; Rt[e * DM + k] = router[i]; }
    __syncthreads();
    const int gw = F.bid * 8 + F.wave, lane = F.lane; const int rpw = NTOK / (F.G * 8);
    bf16_t* xb = (bf16_t*)(F.ws + A_X3B); int* route_e = (int*)(F.ws + WS_ROUTE_E); f32x2* route_g = (f32x2*)(F.ws + WS_ROUTE_G); int* cntw = (int*)(F.ws + WS_CNTW);
    int mycnt = 0;
    for (int rr = 0; rr < rpw; ++rr) {
        const int row = gw * rpw + rr; float* xr = F.out + (size_t)row * DM; f32x4 v[4];
#pragma unroll
        for (int j = 0; j < 4; ++j) v[j] = *(const f32x4*)(xr + 4 * lane + 256 * j);
        ln_core(v, INF(31), INF(32), lane);
#pragma unroll
        for (int j = 0; j < 4; ++j) { *(f32x4*)(xr + 4 * lane + 256 * j) = v[j]; u32x2 o; o.x = pk2(v[j][0], v[j][1]); o.y = pk2(v[j][2], v[j][3]); *(u32x2*)(xb + (size_t)row * DM + 4 * lane + 256 * j) = o; }
        float lg[NEXP];
#pragma unroll
        for (int e = 0; e < NEXP; ++e) { float a = 0.f;
#pragma unroll
            for (int j = 0; j < 4; ++j) { const f32x4 w = *(const f32x4*)(Rt + e * DM + 4 * lane + 256 * j); a += (v[j][0] * w[0] + v[j][1] * w[1]) + (v[j][2] * w[2] + v[j][3] * w[3]); }
            lg[e] = wave_sum(a); }
        int e0 = 0; float v0 = lg[0];
#pragma unroll
        for (int e = 1; e < NEXP; ++e) if (lg[e] > v0) { v0 = lg[e]; e0 = e; }
        int e1 = -1; float v1 = -3.0e38f;
#pragma unroll
        for (int e = 0; e < NEXP; ++e) if (e != e0 && lg[e] > v1) { v1 = lg[e]; e1 = e; }
        const float g0 = 1.0f / (1.0f + expf(v1 - v0)), g1 = 1.0f - g0;
        if (lane == 0) { route_e[row] = e0 | (e1 << 8); route_g[row] = (f32x2){g0, g1}; }
        mycnt += ((lane & 7) == e0 ? 1 : 0) + ((lane & 7) == e1 ? 1 : 0);
    }
    if (lane < NEXP) cntw[lane * 2048 + gw] = mycnt;
}
__device__ __forceinline__ void route_gather_pass(Frame& F) {
    int* lsm = (int*)F.gl;
    const int* cntw = (const int*)(F.ws + WS_CNTW); const int lane = F.lane, w = F.wave, gw0 = F.bid * 8;
    { int tot = 0, pre = 0;
      for (int i = 0; i < 32; ++i) { const int idx = lane + 64 * i; const int v = cntw[w * 2048 + idx]; tot += v; pre += (idx < gw0) ? v : 0; }
#pragma unroll
      for (int o = 1; o < 64; o <<= 1) { tot += __shfl_xor(tot, o); pre += __shfl_xor(pre, o); }
      if (lane == 0) { lsm[w] = tot; lsm[8 + w] = pre; }
      if (lane < 8) lsm[16 + w * 8 + lane] = cntw[w * 2048 + gw0 + lane]; }
    __syncthreads();
    int base_e[NEXP + 1]; { int run = 0;
#pragma unroll
      for (int e = 0; e < NEXP; ++e) { base_e[e] = run; run += (lsm[e] + 255) & ~255; } base_e[NEXP] = run; }
    int* meta = (int*)(F.ws + WS_META);
    if (F.bid == 0 && F.tid == 0) { for (int e = 0; e <= NEXP; ++e) meta[e] = base_e[e]; meta[9] = base_e[NEXP] / 256; }
    int mybase; { const int e = lane & 7; int b = 0;
#pragma unroll
      for (int q = 0; q < NEXP; ++q) b = (q == e) ? base_e[q] : b;
      b += lsm[8 + e]; for (int ww = 0; ww < w; ++ww) b += lsm[16 + e * 8 + ww]; mybase = b; }
    const int gw = gw0 + w; const int row = gw * 16 + (lane & 15);
    const int ee = ((const int*)(F.ws + WS_ROUTE_E))[row]; const int e0 = ee & 255, e1 = ee >> 8;
    int pos0 = 0, pos1 = 0; const unsigned long long below = (1ull << (lane & 15)) - 1ull, self = 1ull << (lane & 15);
#pragma unroll
    for (int e = 0; e < NEXP; ++e) {
        const unsigned long long m0 = __ballot(e0 == e) & 0xffffull, m1 = __ballot(e1 == e) & 0xffffull; const int be = __shfl(mybase, e);
        if (e0 == e) pos0 = be + __popcll(m0 & below) + __popcll(m1 & below);
        if (e1 == e) pos1 = be + __popcll(m0 & (below | self)) + __popcll(m1 & below);
    }
    if (lane < 16) ((int*)(F.ws + WS_ROUTE_POS))[row * 2] = pos0, ((int*)(F.ws + WS_ROUTE_POS))[row * 2 + 1] = pos1;
    const bf16_t* xb = (const bf16_t*)(F.ws + A_X3B); bf16_t* xs = (bf16_t*)(F.ws + A_XSYS);
    for (int r = 0; r < 16; ++r) {
        const int p0 = __shfl(pos0, r), p1 = __shfl(pos1, r); const size_t src = (size_t)(gw * 16 + r) * DM;
        const u32x4 a = *(const u32x4*)(xb + src + lane * 8), b = *(const u32x4*)(xb + src + 512 + lane * 8);
        *(u32x4*)(xs + (size_t)p0 * DM + lane * 8) = a; *(u32x4*)(xs + (size_t)p0 * DM + 512 + lane * 8) = b;
        *(u32x4*)(xs + (size_t)p1 * DM + lane * 8) = a; *(u32x4*)(xs + (size_t)p1 * DM + 512 + lane * 8) = b;
    }
    if (F.bid < NEXP) { const int e = F.bid; const int r0 = base_e[e] + lsm[e], r1 = base_e[e + 1];
        for (int i = r0 * 128 + F.tid; i < r1 * 128; i += 512) ((u32x4*)xs)[i] = (u32x4){0u, 0u, 0u, 0u}; }
    __syncthreads();
}
__device__ __forceinline__ void final_pass(ArgsP args, Frame& F) {
    const int gw = F.bid * 8 + F.wave, NGW = F.G * 8, lane = F.lane;
    const bf16_t* ys = (const bf16_t*)(F.ws + A_XSYS); const f32x2* route_g = (const f32x2*)(F.ws + WS_ROUTE_G); const int* route_pos = (const int*)(F.ws + WS_ROUTE_POS);
    for (int row = gw; row < NTOK; row += NGW) {
        float* xr = F.out + (size_t)row * DM; f32x4 v[4];
#if !SKIP_MOE
        const f32x2 gg = route_g[row]; const int p0 = route_pos[row * 2], p1 = route_pos[row * 2 + 1];
#endif
#pragma unroll
        for (int j = 0; j < 4; ++j) { v[j] = *(const f32x4*)(xr + 4 * lane + 256 * j) * DN_ALPHA;
#if !SKIP_MOE
            const u32x2 a = *(const u32x2*)(ys + (size_t)p0 * DM + 4 * lane + 256 * j), b = *(const u32x2*)(ys + (size_t)p1 * DM + 4 * lane + 256 * j);
            v[j][0] += gg.x * bflo(a.x) + gg.y * bflo(b.x); v[j][1] += gg.x * bfhi(a.x) + gg.y * bfhi(b.x); v[j][2] += gg.x * bflo(a.y) + gg.y * bflo(b.y); v[j][3] += gg.x * bfhi(a.y) + gg.y * bfhi(b.y);
#endif
        }
        ln_core(v, INF(37), INF(38), lane);
#pragma unroll
        for (int j = 0; j < 4; ++j) *(f32x4*)(xr + 4 * lane + 256 * j) = v[j];
    }
}

__device__ __forceinline__ void s5_scan_pass(Frame& F) {
    const int gw = F.bid * 8 + F.wave, NGW = F.G * 8, lane = F.lane;
    const float* sloc = (const float*)(F.ws + A_SLOC); bf16_t* ug = (bf16_t*)(F.ws + A_UG); const f32x2* a16 = (const f32x2*)(F.ws + WS_A16);
    for (int idx = gw; idx < S5G * NBATCH; idx += NGW) {
        const int g = idx >> 4, b = idx & 15; const f32x2 A = a16[g * 64 + lane]; float hr = 0.f, hi = 0.f;
        const float* sp = sloc + ((size_t)g * S5ROWS + b * 128) * 128; bf16_t* up = ug + (size_t)g * (S5ROWS * UGLD) + (size_t)(b * 128) * UGLD + 256;
        for (int k0 = 0; k0 < 128; k0 += 8) {
            float sr[8], si[8];
#pragma unroll
            for (int i = 0; i < 8; ++i) { sr[i] = sp[(size_t)(k0 + i) * 128 + lane]; si[i] = sp[(size_t)(k0 + i) * 128 + 64 + lane]; }
#pragma unroll
            for (int i = 0; i < 8; ++i) { up[(size_t)(k0 + i) * UGLD + lane] = (bf16_t)f2bf(hr); up[(size_t)(k0 + i) * UGLD + 64 + lane] = (bf16_t)f2bf(hi);
                const float nr = A.x * hr - A.y * hi + sr[i], ni = A.x * hi + A.y * hr + si[i]; hr = nr; hi = ni; }
        }
    }
}

constexpr int VN_LD = 136;
__device__ __forceinline__ void gate_unit(ArgsP args, Frame& F, int unit) {
    const int tid = F.tid, lane = F.lane, wid = F.wave, r32 = lane & 31, hi = lane >> 5;
    const size_t tok0 = (size_t)unit * 128;
    const bf16_t* Vb = (const bf16_t*)(F.ws + A_V); const bf16_t* Ub = (const bf16_t*)(F.ws + A_U); bf16_t* Y = (bf16_t*)(F.ws + A_YCAT); const bf16_t* Wsb = (const bf16_t*)(F.ws + WS_WSB);
    bf16_t* vnT = (bf16_t*)F.gl;
    { const int tk = tid >> 2, part = tid & 3; const bf16_t* vp = Vb + (tok0 + tk) * AW + part * 128; u32x4 raw[16]; float s = 0.f, q = 0.f;
#pragma unroll
      for (int i = 0; i < 16; ++i) { raw[i] = *(const u32x4*)(vp + i * 8);
          const float a0 = bflo(raw[i].x), a1 = bfhi(raw[i].x), a2 = bflo(raw[i].y), a3 = bfhi(raw[i].y), a4 = bflo(raw[i].z), a5 = bfhi(raw[i].z), a6 = bflo(raw[i].w), a7 = bfhi(raw[i].w);
          s += ((a0 + a1) + (a2 + a3)) + ((a4 + a5) + (a6 + a7)); q += ((a0 * a0 + a1 * a1) + (a2 * a2 + a3 * a3)) + ((a4 * a4 + a5 * a5) + (a6 * a6 + a7 * a7)); }
      s += __shfl_xor(s, 1); s += __shfl_xor(s, 2); q += __shfl_xor(q, 1); q += __shfl_xor(q, 2);
      const float mean = s * (1.0f / AW); const float var = fmaxf(q * (1.0f / AW) - mean * mean, 0.f); const float rstd = 1.0f / sqrtf(var + LN_EPS);
      const float* lg = INF(3) + part * 128; const float* lb = INF(4) + part * 128;
#pragma unroll
      for (int i = 0; i < 16; ++i) { const unsigned wv[4] = {raw[i].x, raw[i].y, raw[i].z, raw[i].w};
#pragma unroll
          for (int j = 0; j < 4; ++j) { const int c = i * 8 + 2 * j; const float y0 = (bflo(wv[j]) - mean) * rstd * lg[c] + lb[c], y1 = (bfhi(wv[j]) - mean) * rstd * lg[c + 1] + lb[c + 1];
              vnT[(part * 128 + c) * VN_LD + tk] = (bf16_t)f2bf(y0); vnT[(part * 128 + c + 1) * VN_LD + tk] = (bf16_t)f2bf(y1); } }
    }
    __syncthreads();
    const int cb = wid & 3;
    const float* bsv = INF(6);
    for (int h = 0; h < 4; ++h) {
#pragma unroll
        for (int tt = 0; tt < 2; ++tt) {
            const int tb = (wid >> 2) + 2 * tt; f32x16 acc = {};
            const bf16_t* ap = vnT + (h * 128 + cb * 32 + r32) * VN_LD + hi * 8; const bf16_t* bp = Wsb + ((size_t)h * 128 + tb * 32 + r32) * 128 + hi * 8;
            for (int ss = 0; ss <= 2 * tb + 1; ++ss) { const bf16x8 a = *(const bf16x8*)(ap + ss * 16); const bf16x8 b = *(const bf16x8*)(bp + ss * 16); acc = __builtin_amdgcn_mfma_f32_32x32x16_bf16(a, b, acc, 0, 0, 0); }
            const int t = tb * 32 + r32; const float bias = bsv[h * 128 + t];
#pragma unroll
            for (int g4 = 0; g4 < 4; ++g4) { const int c0 = h * 128 + cb * 32 + 8 * g4 + 4 * hi; const u32x2 uu = *(const u32x2*)(Ub + (tok0 + t) * AW + c0);
                u32x2 o; o.x = pk2(bflo(uu.x) * (acc[4 * g4] + bias), bfhi(uu.x) * (acc[4 * g4 + 1] + bias)); o.y = pk2(bflo(uu.y) * (acc[4 * g4 + 2] + bias), bfhi(uu.y) * (acc[4 * g4 + 3] + bias));
                *(u32x2*)(Y + (tok0 + t) * DM + c0) = o; }
        }
    }
    __syncthreads();
}

constexpr int KS_LD = 104, VS_LD = 68;
constexpr int KS_BYTES = 64 * KS_LD * 2, VS_BYTES = 64 * VS_LD * 2;
constexpr int AT_K0 = 0, AT_V0 = 2 * KS_BYTES, AT_STG = AT_V0 + 2 * VS_BYTES, OST_LD = 72;
__device__ __forceinline__ int crow(int r, int hi) { return (r & 3) + 8 * (r >> 2) + 4 * hi; }
__device__ __forceinline__ void attn_unit(Frame& F, int b, int h, int qb) {
    const int tid = F.tid, lane = F.lane, wid = F.wave, r32 = lane & 31, hi = lane >> 5;
    const bf16_t* Q = (const bf16_t*)(F.ws + A_Q); const bf16_t* Kg = (const bf16_t*)(F.ws + A_KB); const bf16_t* Vt = (const bf16_t*)(F.ws + A_VT); bf16_t* Y = (bf16_t*)(F.ws + A_YCAT);
    unsigned char* sm = F.gl;
    const int q0 = qb * 256, qrow = q0 + wid * 32 + r32; const size_t tokq = (size_t)b * SEQ + qrow;
    bf16x8 qf[6];
#pragma unroll
    for (int ds = 0; ds < 6; ++ds) qf[ds] = *(const bf16x8*)(Q + tokq * 768 + h * QKH + ds * 16 + hi * 8);
    f32x16 o0 = {}, o1 = {}; float mrun = -1.0e30f, lrun = 0.f;
    const int NT = (q0 + 256) / 64;
    const int kr0 = tid / 12, kc0 = tid % 12, kr1 = (512 + tid) / 12, kc1 = (512 + tid) % 12, vd = tid >> 3, vc = tid & 7;
    const bf16_t* kbase = Kg + (size_t)b * SEQ * 768 + h * QKH; const bf16_t* vbase = Vt + ((size_t)(b * NH + h) * VH + vd) * SEQ + vc * 8;
    u32x4 rk0, rk1 = {}, rv;
#define AT_LOAD(kt) do { rk0 = *(const u32x4*)(kbase + (size_t)((kt) * 64 + kr0) * 768 + kc0 * 8); if (tid < 256) rk1 = *(const u32x4*)(kbase + (size_t)((kt) * 64 + kr1) * 768 + kc1 * 8); rv = *(const u32x4*)(vbase + (kt) * 64); } while (0)
#define AT_STORE(buf) do { *(u32x4*)(sm + AT_K0 + (buf) * KS_BYTES + kr0 * (KS_LD * 2) + kc0 * 16) = rk0; if (tid < 256) *(u32x4*)(sm + AT_K0 + (buf) * KS_BYTES + kr1 * (KS_LD * 2) + kc1 * 16) = rk1; \
        *(u32x2*)(sm + AT_V0 + (buf) * VS_BYTES + vd * (VS_LD * 2) + vc * 16) = (u32x2){rv.x, rv.y}; *(u32x2*)(sm + AT_V0 + (buf) * VS_BYTES + vd * (VS_LD * 2) + vc * 16 + 8) = (u32x2){rv.z, rv.w}; } while (0)
    AT_LOAD(0); AT_STORE(0); __syncthreads();
    for (int kt = 0; kt < NT; ++kt) {
        const int buf = kt & 1;
        if (kt + 1 < NT) AT_LOAD(kt + 1);
        if (kt * 64 <= q0 + wid * 32 + 31) {
            const unsigned char* ks = sm + AT_K0 + buf * KS_BYTES; const unsigned char* vs = sm + AT_V0 + buf * VS_BYTES;
            f32x16 p0 = {}, p1 = {};
#pragma unroll
            for (int ds = 0; ds < 6; ++ds) { const bf16x8 k0 = *(const bf16x8*)(ks + r32 * (KS_LD * 2) + ds * 32 + hi * 16), k1 = *(const bf16x8*)(ks + (32 + r32) * (KS_LD * 2) + ds * 32 + hi * 16);
                p0 = __builtin_amdgcn_mfma_f32_32x32x16_bf16(k0, qf[ds], p0, 0, 0, 0); p1 = __builtin_amdgcn_mfma_f32_32x32x16_bf16(k1, qf[ds], p1, 0, 0, 0); }
            if (kt * 64 + 63 > q0 + wid * 32) {
#pragma unroll
                for (int r = 0; r < 16; ++r) { const int key = kt * 64 + crow(r, hi); if (key > qrow) p0[r] = -1.0e30f; if (key + 32 > qrow) p1[r] = -1.0e30f; }
            }
            float mx = p0[0];
#pragma unroll
            for (int r = 1; r < 16; ++r) mx = fmaxf(mx, p0[r]);
#pragma unroll
            for (int r = 0; r < 16; ++r) mx = fmaxf(mx, p1[r]);
            mx = fmaxf(mx, __shfl_xor(mx, 32));
            const float mnew = fmaxf(mrun, mx), al = __builtin_amdgcn_exp2f(mrun - mnew); mrun = mnew;
            float sum = 0.f;
#pragma unroll
            for (int r = 0; r < 16; ++r) { p0[r] = __builtin_amdgcn_exp2f(p0[r] - mnew); p1[r] = __builtin_amdgcn_exp2f(p1[r] - mnew); sum += p0[r] + p1[r]; }
            lrun = lrun * al + sum;
#pragma unroll
            for (int r = 0; r < 16; ++r) { o0[r] *= al; o1[r] *= al; }
#pragma unroll
            for (int half = 0; half < 2; ++half) {
#pragma unroll
                for (int s = 0; s < 2; ++s) {
                    u32x4 pw;
                    if (half == 0) { pw.x = pk2(p0[8 * s], p0[8 * s + 1]); pw.y = pk2(p0[8 * s + 2], p0[8 * s + 3]); pw.z = pk2(p0[8 * s + 4], p0[8 * s + 5]); pw.w = pk2(p0[8 * s + 6], p0[8 * s + 7]); }
                    else { pw.x = pk2(p1[8 * s], p1[8 * s + 1]); pw.y = pk2(p1[8 * s + 2], p1[8 * s + 3]); pw.z = pk2(p1[8 * s + 4], p1[8 * s + 5]); pw.w = pk2(p1[8 * s + 6], p1[8 * s + 7]); }
                    const bf16x8 pf = __builtin_bit_cast(bf16x8, pw);
                    const int kvo = (32 * half + 16 * s + 4 * hi) * 2;
                    { const unsigned char* vp = vs + r32 * (VS_LD * 2) + kvo; const u32x2 lo = *(const u32x2*)vp, hh = *(const u32x2*)(vp + 16); const bf16x8 vf = __builtin_bit_cast(bf16x8, (u32x4){lo.x, lo.y, hh.x, hh.y});
                      o0 = __builtin_amdgcn_mfma_f32_32x32x16_bf16(vf, pf, o0, 0, 0, 0); }
                    { const unsigned char* vp = vs + (32 + r32) * (VS_LD * 2) + kvo; const u32x2 lo = *(const u32x2*)vp, hh = *(const u32x2*)(vp + 16); const bf16x8 vf = __builtin_bit_cast(bf16x8, (u32x4){lo.x, lo.y, hh.x, hh.y});
                      o1 = __builtin_amdgcn_mfma_f32_32x32x16_bf16(vf, pf, o1, 0, 0, 0); }
                }
            }
        }
        if (kt + 1 < NT) AT_STORE((kt + 1) & 1);
        __syncthreads();
    }
#undef AT_LOAD
#undef AT_STORE
    lrun += __shfl_xor(lrun, 32); const float inv = 1.0f / lrun;
    bf16_t* stg = (bf16_t*)(sm + AT_STG) + wid * 32 * OST_LD;
#pragma unroll
    for (int r = 0; r < 16; ++r) { const int d = crow(r, hi); stg[r32 * OST_LD + d] = (bf16_t)f2bf(o0[r] * inv); stg[r32 * OST_LD + 32 + d] = (bf16_t)f2bf(o1[r] * inv); }
    LDS_WAIT(); asm volatile("" ::: "memory");
#pragma unroll
    for (int i = 0; i < 4; ++i) { const int rr = i * 8 + (lane >> 3), ch = lane & 7; const u32x4 v = *(const u32x4*)(stg + rr * OST_LD + ch * 8);
        *(u32x4*)(Y + ((size_t)b * SEQ + q0 + wid * 32 + rr) * DM + AW + h * VH + ch * 8) = v; }
    __syncthreads();
}

enum { PH_PRO = 0, PH_IN, PH_QKV, PH_MIX, PH_OUT, PH_LN1, PH_FGU, PH_FDN, PH_LN2, PH_CIN, PH_S1, PH_SCAN, PH_S2, PH_GLU, PH_COUT, PH_LN3, PH_ROUTE, PH_MGU, PH_MDN, PH_FINAL, PH_COUNT };

__global__ void __launch_bounds__(512, 2) fwd_kernel(Args args_byval) {
    ArgsP args = args_now();
    extern __shared__ __attribute__((aligned(16))) unsigned char lds_raw[];
    Frame F;
    F.lds = (LAS unsigned char*)lds_raw; F.gl = lds_raw; F.ws = args->ws; F.out = args->out;
    F.tid = threadIdx.x; F.lane = F.tid & 63; F.wave = __builtin_amdgcn_readfirstlane(F.tid >> 6); F.G = gridDim.x; F.bid = blockIdx.x;
    volatile LAS unsigned* MISC = (volatile LAS unsigned*)(F.lds + MISC_OFF);
    for (int u = F.tid; u < (LDS_BYTES - MISC_OFF) / 4; u += 512) MISC[u] = 0u;
    __syncthreads();
    int lo = args->ph_lo, hi = args->ph_hi;
    bool multi = (hi - lo) > 1;
    if (multi) (void)xcd_barrier_post((unsigned*)(F.ws + WS_CTL + CTL_BAR), MISC + 8);
#ifndef ONLY_PHASE
#define ONLY_PHASE -1
#endif
#define IN(k) ((ONLY_PHASE < 0 || ONLY_PHASE == (k)) && lo <= (k) && (k) < hi)
#define REFRESH() do { args = args_now(); { int t_ = threadIdx.x; asm volatile("" : "+v"(t_)); F.tid = t_; F.lane = t_ & 63; F.wave = __builtin_amdgcn_readfirstlane(t_ >> 6); } F.ws = args->ws; F.out = args->out; ws = F.ws; lo = args->ph_lo; hi = args->ph_hi; multi = (hi - lo) > 1; } while (0)
#define GRID_BAR() do { XcdBarrier b_; b_.bar = (unsigned*)(F.ws + WS_CTL + CTL_BAR); b_.x = xb_xcc_id(); b_.st = (volatile LAS unsigned*)(F.lds + MISC_OFF) + 8; xcd_barrier(b_); } while (0)
#define SEAM(k) do { if (IN(k) && IN((k) + 1)) GRID_BAR(); REFRESH(); } while (0)
    unsigned char* ws = F.ws;
#define ssq ((float*)(ws + WS_CTL + CTL_SSQ))
#define cs ((const float*)(ws + WS_CS))

    if (IN(PH_PRO)) { p0_prologue(args, F); __syncthreads(); }
    SEAM(PH_PRO);
    if (IN(PH_IN)) {
#if !SKIP_AB
        pg8::SchedPlain S; S.init(NTOK, NIN_PAD, F.G, F.bid, ws + A_XB, DM, ws + W_IN, DM);
        EpiIn E{(bf16_t*)(ws + A_U), (bf16_t*)(ws + A_V), (bf16_t*)(ws + A_CBUF), (bf16_t*)(ws + A_KB), ssq, cs};
        pg8::gemm_phase<EpiIn, pg8::SchedPlain, true, true>(F.lds, DM, DM, S, E);
#endif
    }
    SEAM(PH_IN);
    if (IN(PH_QKV)) {
#if !SKIP_AB
#ifndef NO_QG
        { pg8::SchedPlain S; S.init(NTOK, NH * QKH, F.G, F.bid, ws + A_CBUF, 768, ws + W_UQ, QL);
          EpiQ E{(bf16_t*)(ws + A_Q), ssq, cs};
          pg8::gemm_phase<EpiQ, pg8::SchedPlain, true, true>(F.lds, 768, QL, S, E); }
#endif
#ifndef NO_KVG
        { pg8::SchedPlain S; S.init(NTOK, NH * 128, F.G, F.bid, ws + A_CBUF + QL * 2, 768, ws + W_UKV, KVL);
          EpiKV E{(bf16_t*)(ws + A_KB), (bf16_t*)(ws + A_VT), ssq};
          pg8::gemm_phase<EpiKV, pg8::SchedPlain, true, true>(F.lds, 768, KVL, S, E); }
#endif
#endif
    }
    SEAM(PH_QKV);
    if (IN(PH_MIX)) {
#if !SKIP_AB
#if !SKIP_GATE
        for (int u = F.bid; u < NTOK / 128; u += F.G) gate_unit(args, F, u);
#else
        { u32x4* y = (u32x4*)(ws + A_YCAT); for (size_t i = (size_t)F.bid * 512 + F.tid; i < (size_t)NTOK * 64; i += (size_t)F.G * 512) { const size_t r = i >> 6, c = i & 63; y[r * 128 + c] = (u32x4){0u, 0u, 0u, 0u}; } }
#endif
#if !SKIP_ATT
        {
          if (F.bid < 256) { const int bh = F.bid >> 1, odd = F.bid & 1;
              for (int i = 0; i < 4; ++i) { const int qb = odd ? ((i == 0) ? 1 : (i == 1) ? 6 : (i == 2) ? 3 : 4) : ((i == 0) ? 0 : (i == 1) ? 7 : (i == 2) ? 2 : 5); attn_unit(F, bh >> 3, bh & 7, qb); } }
        }
#else
        { u32x4* y = (u32x4*)(ws + A_YCAT); for (size_t i = (size_t)F.bid * 512 + F.tid; i < (size_t)NTOK * 64; i += (size_t)F.G * 512) { const size_t r = i >> 6, c = i & 63; y[r * 128 + 64 + c] = (u32x4){0u, 0u, 0u, 0u}; } }
#endif
#endif
    }
    SEAM(PH_MIX);
    if (IN(PH_OUT)) {
#if !SKIP_AB
        pg8::SchedPlain S; S.init(NTOK, DM, F.G, F.bid, ws + A_YCAT, DM, ws + W_OUT, DM);
        EpiRes E{INF(0), F.out};
        pg8::gemm_phase<EpiRes, pg8::SchedPlain, true, true>(F.lds, DM, DM, S, E);
#else
        scale_pass(F, INF(0));
#endif
    }
    SEAM(PH_OUT);
    if (IN(PH_LN1)) ln_pass(F, INF(12), INF(13), (bf16_t*)(ws + A_X1B));
    SEAM(PH_LN1);
    if (IN(PH_FGU)) {
#if !SKIP_FFN
        pg8::SchedPlain S; S.init(NTOK, 2 * DFF, F.G, F.bid, ws + A_X1B, DM, ws + W_GU, DM);
        EpiGU E{(bf16_t*)(ws + A_HFF), DFF};
        pg8::gemm_phase<EpiGU, pg8::SchedPlain, true, true>(F.lds, DM, DM, S, E);
#endif
    }
    SEAM(PH_FGU);
    if (IN(PH_FDN)) {
#if !SKIP_FFN
        pg8::SchedPlain S; S.init(NTOK, DM, F.G, F.bid, ws + A_HFF, DFF, ws + W_D, DFF);
        EpiRes E{F.out, F.out};
        pg8::gemm_phase<EpiRes, pg8::SchedPlain, true, true>(F.lds, DFF, DFF, S, E);
#else
        scale_pass(F, F.out);
#endif
    }
    SEAM(PH_FDN);
    if (IN(PH_LN2)) ln_pass(F, INF(17), INF(18), (bf16_t*)(ws + A_X2B));
    SEAM(PH_LN2);
    if (IN(PH_CIN)) {
#if !SKIP_S5
        pg8::SchedPlain S; S.init(NTOK, DM, F.G, F.bid, ws + A_X2B, DM, ws + W_CIN, DM);
        EpiCin E{(bf16_t*)(ws + A_UG)};
        pg8::gemm_phase<EpiCin, pg8::SchedPlain, true, true>(F.lds, DM, DM, S, E);
#endif
    }
    SEAM(PH_CIN);
    if (IN(PH_S1)) {
#if !SKIP_S5
        pg8::SchedS5 S{F.G, F.bid, (const char*)(ws + A_UG), (const char*)(ws + W_S1), (size_t)S5ROWS * UGLD * 2, (size_t)256 * 256 * 2, (size_t)256 * UGLD * 2};
        EpiS1 E{(float*)(ws + A_SLOC)};
        pg8::gemm_phase<EpiS1, pg8::SchedS5, true, true>(F.lds, UGLD, 256, S, E);
#endif
    }
    SEAM(PH_S1);
    if (IN(PH_SCAN)) {
#if !SKIP_S5
        s5_scan_pass(F);
#endif
    }
    SEAM(PH_SCAN);
    if (IN(PH_S2)) {
#if !SKIP_S5
        pg8::SchedS5 S{F.G, F.bid, (const char*)(ws + A_UG), (const char*)(ws + W_S2), (size_t)S5ROWS * UGLD * 2, (size_t)256 * UGLD * 2, (size_t)256 * UGLD * 2};
        EpiS2 E{(const bf16_t*)(ws + A_UG), INF(27), (bf16_t*)(ws + A_GACT)};
        pg8::gemm_phase<EpiS2, pg8::SchedS5, true, true>(F.lds, UGLD, UGLD, S, E);
#endif
    }
    SEAM(PH_S2);
    if (IN(PH_GLU)) {
#if !SKIP_S5
        pg8::SchedPlain S; S.init(NTOK, DM, F.G, F.bid, ws + A_GACT, DM, ws + W_GLU, DM);
        EpiGlu E{(const bf16_t*)(ws + A_GACT), INF(29), (bf16_t*)(ws + A_Z)};
        pg8::gemm_phase<EpiGlu, pg8::SchedPlain, true, true>(F.lds, DM, DM, S, E);
#endif
    }
    SEAM(PH_GLU);
    if (IN(PH_COUT)) {
#if !SKIP_S5
        pg8::SchedPlain S; S.init(NTOK, DM, F.G, F.bid, ws + A_Z, DM, ws + W_COUT, DM);
        EpiRes E{F.out, F.out};
        pg8::gemm_phase<EpiRes, pg8::SchedPlain, true, true>(F.lds, DM, DM, S, E);
#else
        scale_pass(F, F.out);
#endif
    }
    SEAM(PH_COUT);
    if (IN(PH_LN3)) { ln3_router_pass(args, F); __syncthreads(); }
    SEAM(PH_LN3);
    if (IN(PH_ROUTE)) {
#if !SKIP_MOE
        route_gather_pass(F);
#endif
    }
    SEAM(PH_ROUTE);
#if !SKIP_MOE
    if (IN(PH_MGU) || IN(PH_MDN)) {
        const int* meta = (const int*)(ws + WS_META); const int T = meta[9];
        const int ck_lo = args->ck_lo, ck_hi = args->ck_hi;
        for (int ck = ck_lo; ck < ck_hi; ++ck) {
            const int t0 = ck * MOE_CHUNK; int ntc = T - t0; ntc = ntc > MOE_CHUNK ? MOE_CHUNK : ntc;
            if (IN(PH_MGU) && ntc > 0) {
                pg8::SchedMoE S{F.G, F.bid, t0, ntc, 28, meta, (const char*)(ws + A_XSYS), (const char*)(ws + W_MGU), (size_t)256 * DM * 2, (size_t)7168 * DM * 2, (size_t)256 * DM * 2, true};
                EpiGU E{(bf16_t*)(ws + A_HM), DEXP};
                pg8::gemm_phase<EpiGU, pg8::SchedMoE, true, true>(F.lds, DM, DM, S, E);
            }
            if (multi) GRID_BAR();
            REFRESH();
            if (IN(PH_MDN) && ntc > 0) {
                pg8::SchedMoE S{F.G, F.bid, t0, ntc, 4, meta, (const char*)(ws + A_HM), (const char*)(ws + W_MDN), (size_t)256 * DEXP * 2, (size_t)DM * DEXP * 2, (size_t)256 * DEXP * 2, false};
                EpiDn E{(bf16_t*)(ws + A_XSYS)};
                pg8::gemm_phase<EpiDn, pg8::SchedMoE, true, true>(F.lds, DEXP, DEXP, S, E);
            }
            if (multi) GRID_BAR();
            REFRESH();
        }
    }
#endif
    if (IN(PH_FINAL)) final_pass(args, F);
#undef IN
#undef SEAM
#undef ssq
#undef cs
}

extern "C" void kernel_launch(void* const* d_in, const int* in_sizes, int n_in, void* d_out, int out_size, void* d_ws, size_t ws_size, hipStream_t stream) {
    static int grid = 0;
    if (grid == 0) {
        if (n_in != 39 || out_size != NTOK * DM || ws_size < WS_END) { fprintf(stderr, "kernel_launch: unexpected problem (n_in %d, out %d, ws %zu < %zu)\n", n_in, out_size, ws_size, (size_t)WS_END); grid = -1; return; }
        int dev = 0, cus = 0, per_cu = 0;
        if (hipGetDevice(&dev) != hipSuccess || hipDeviceGetAttribute(&cus, hipDeviceAttributeMultiprocessorCount, dev) != hipSuccess) { grid = -1; return; }
        if (hipFuncSetAttribute((const void*)fwd_kernel, hipFuncAttributeMaxDynamicSharedMemorySize, LDS_BYTES) != hipSuccess) { fprintf(stderr, "kernel_launch: hipFuncSetAttribute failed\n"); grid = -1; return; }
        if (hipOccupancyMaxActiveBlocksPerMultiprocessor(&per_cu, (const void*)fwd_kernel, 512, LDS_BYTES) != hipSuccess || per_cu < 1) fprintf(stderr, "kernel_launch: occupancy query says %d\n", per_cu);
        (void)hipGetLastError();
        grid = cus;
        if (grid != 256) { fprintf(stderr, "kernel_launch: %d CUs; this kernel is built for 256\n", cus); grid = 256; }
    }
    if (grid < 0) return;
    (void)hipMemsetAsync((char*)d_ws + WS_CTL, 0, CTL_ZERO_BYTES, stream);
    Args a{};
    for (int i = 0; i < 39; ++i) a.in[i] = d_in[i];
    a.out = (float*)d_out; a.ws = (unsigned char*)d_ws;
#if MK_PER_PHASE
    for (int ph = 0; ph < PH_COUNT; ++ph) {
        if (ph == PH_MGU) {
#if !SKIP_MOE
            for (int ck = 0; ck < MOE_NCHUNK; ++ck) {
                a.ck_lo = ck; a.ck_hi = ck + 1;
                a.ph_lo = PH_MGU; a.ph_hi = PH_MGU + 1; hipLaunchKernelGGL(fwd_kernel, dim3(grid), dim3(512), LDS_BYTES, stream, a);
                a.ph_lo = PH_MDN; a.ph_hi = PH_MDN + 1; hipLaunchKernelGGL(fwd_kernel, dim3(grid), dim3(512), LDS_BYTES, stream, a);
            }
#endif
            ++ph; continue;
        }
        a.ck_lo = 0; a.ck_hi = 0; a.ph_lo = ph; a.ph_hi = ph + 1;
        hipLaunchKernelGGL(fwd_kernel, dim3(grid), dim3(512), LDS_BYTES, stream, a);
    }
#else
    a.ph_lo = 0; a.ph_hi = PH_COUNT; a.ck_lo = 0; a.ck_hi = MOE_NCHUNK;
    hipLaunchKernelGGL(fwd_kernel, dim3(grid), dim3(512), LDS_BYTES, stream, a);
#endif
    const hipError_t le = hipPeekAtLastError();
    if (le != hipSuccess) fprintf(stderr, "kernel_launch: launch failed: %s\n", hipGetErrorName(le));
}
```
